# Optimizing an MI355X kernel written in HIP

```python
import jax, jax.numpy as jnp
from jax import lax
import numpy as np

D_MODEL = 1024
BATCH = 2
SEQ = 16384
DEPTH = 1
DEC_BATCH = 8
DEC_SEQ = 4096
PAST_LEN = 128

PLE_DIM = 256
BLOCK = 128
WINDOW = 128
SWA_HEADS = 8
SWA_KV_HEADS = 2
SWA_GROUP = SWA_HEADS // SWA_KV_HEADS
SWA_HEAD_DIM = 64
MLA_HEADS = 8
MLA_NOPE_DIM = 64
MLA_ROPE_DIM = 32
MLA_V_DIM = 64
MLA_Q_RANK = 256
MLA_KV_RANK = 128
ROPE_THETA = 10000.0
D_FF = 2816
EPS = 1e-6
NEG_INF = -1e30

SWA_Q_W = SWA_HEADS * SWA_HEAD_DIM
SWA_KV_W = SWA_KV_HEADS * SWA_HEAD_DIM
SWA_OUT_W = SWA_HEADS * SWA_HEAD_DIM
MLA_OUT_W = MLA_HEADS * MLA_V_DIM
MIX_W = SWA_OUT_W + MLA_OUT_W
OFF_Q = 0
OFF_K = OFF_Q + SWA_Q_W
OFF_V = OFF_K + SWA_KV_W
OFF_CQ = OFF_V + SWA_KV_W
OFF_CKV = OFF_CQ + MLA_Q_RANK
OFF_KR = OFF_CKV + MLA_KV_RANK
IN_W = OFF_KR + MLA_ROPE_DIM

kernel_name = "hymba_swa_mla_encoder"


def rmsnorm(x, g):
    xf = x.astype(jnp.float32)
    r = lax.rsqrt(jnp.mean(xf * xf, axis=-1, keepdims=True) + EPS)
    return (xf * r).astype(x.dtype) * g


def alibi_slopes():
    s = 2.0 ** (-8.0 * np.arange(1, SWA_HEADS + 1, dtype=np.float32) / SWA_HEADS)
    return jnp.asarray(s, dtype=jnp.float32).reshape(SWA_KV_HEADS, SWA_GROUP)


def rope(x):
    S, D = x.shape[1], x.shape[-1]
    half = D // 2
    inv = ROPE_THETA ** (-jnp.arange(half, dtype=jnp.float32) / half)
    ang = jnp.arange(S, dtype=jnp.float32)[:, None] * inv[None, :]
    shape = (S,) + (1,) * (x.ndim - 3) + (half,)
    cos = jnp.cos(ang).reshape(shape).astype(x.dtype)
    sin = jnp.sin(ang).reshape(shape).astype(x.dtype)
    x1, x2 = x[..., :half], x[..., half:]
    return jnp.concatenate([x1 * cos - x2 * sin, x2 * cos + x1 * sin], axis=-1)


def swa_attention(q, k, v, sink):
    B, S = q.shape[0], q.shape[1]
    nb = S // BLOCK
    qb = q.reshape(B, nb, BLOCK, SWA_KV_HEADS, SWA_GROUP, SWA_HEAD_DIM)
    pad = ((0, 0), (BLOCK, BLOCK), (0, 0), (0, 0))
    kp = jnp.pad(k, pad).reshape(B, nb + 2, BLOCK, SWA_KV_HEADS, SWA_HEAD_DIM)
    vp = jnp.pad(v, pad).reshape(B, nb + 2, BLOCK, SWA_KV_HEADS, SWA_HEAD_DIM)
    kb = jnp.concatenate([kp[:, :-2], kp[:, 1:-1], kp[:, 2:]], axis=2)
    vb = jnp.concatenate([vp[:, :-2], vp[:, 1:-1], vp[:, 2:]], axis=2)
    s = jnp.einsum('bnqkgd,bnckd->bnkgqc', qb, kb).astype(jnp.float32) * (SWA_HEAD_DIM ** -0.5)
    a = jnp.arange(BLOCK)[:, None]
    c = jnp.arange(3 * BLOCK)[None, :]
    rel = c - BLOCK - a
    key_pos = jnp.arange(nb)[:, None] * BLOCK + jnp.arange(3 * BLOCK)[None, :] - BLOCK
    valid = (jnp.abs(rel) <= WINDOW)[None] & ((key_pos >= 0) & (key_pos < S))[:, None, :]
    dist = jnp.abs(rel).astype(jnp.float32)
    s = s - alibi_slopes()[:, :, None, None] * dist
    s = jnp.where(valid[None, :, None, None], s, NEG_INF)
    sink_b = sink.astype(jnp.float32).reshape(SWA_KV_HEADS, SWA_GROUP)[:, :, None, None]
    m = jnp.maximum(jnp.max(s, axis=-1, keepdims=True), sink_b)
    e = jnp.exp(s - m)
    den = jnp.sum(e, axis=-1, keepdims=True) + jnp.exp(sink_b - m)
    o = jnp.einsum('bnkgqc,bnckd->bnqkgd', (e / den).astype(v.dtype), vb)
    return o.reshape(B, S, SWA_OUT_W)


def mla_attention(q_nope, q_rope, k_nope, k_rope, v):
    B, S = q_nope.shape[0], q_nope.shape[1]
    nb = S // BLOCK
    scale = (MLA_NOPE_DIM + MLA_ROPE_DIM) ** -0.5

    def to_blocks(t):
        return jnp.moveaxis(t.reshape((B, nb, BLOCK) + t.shape[2:]), 1, 0)

    def one_block(qs):
        qn, qr = qs
        s = jnp.einsum('bqhd,bshd->bhqs', qn, k_nope) + jnp.einsum('bqhd,bsd->bhqs', qr, k_rope)
        p = jax.nn.softmax(s.astype(jnp.float32) * scale, axis=-1)
        return jnp.einsum('bhqs,bshd->bqhd', p.astype(v.dtype), v)

    o = lax.map(one_block, (to_blocks(q_nope), to_blocks(q_rope)))
    return jnp.moveaxis(o, 0, 1).reshape(B, S, MLA_OUT_W)


def encoder_layer(h, p_i, g_mix, w_in, g_cq, w_uq, g_ckv, w_ukv, sink, g_swa_out, g_mla_out, w_o,
                  g_ffn, w_ffn_gate, w_ffn_up, w_ffn_down, g_ple, w_ple_gate, w_ple_proj):
    B, S = h.shape[0], h.shape[1]
    n = rmsnorm(h, g_mix)
    proj = n @ w_in
    q = proj[..., OFF_Q:OFF_K].reshape(B, S, SWA_HEADS, SWA_HEAD_DIM)
    k = proj[..., OFF_K:OFF_V].reshape(B, S, SWA_KV_HEADS, SWA_HEAD_DIM)
    v = proj[..., OFF_V:OFF_CQ].reshape(B, S, SWA_KV_HEADS, SWA_HEAD_DIM)
    o_swa = swa_attention(q, k, v, sink)
    c_q = rmsnorm(proj[..., OFF_CQ:OFF_CKV], g_cq)
    qm = (c_q @ w_uq).reshape(B, S, MLA_HEADS, MLA_NOPE_DIM + MLA_ROPE_DIM)
    q_nope, q_rope = qm[..., :MLA_NOPE_DIM], rope(qm[..., MLA_NOPE_DIM:])
    c_kv = rmsnorm(proj[..., OFF_CKV:OFF_KR], g_ckv)
    kv = (c_kv @ w_ukv).reshape(B, S, MLA_HEADS, MLA_NOPE_DIM + MLA_V_DIM)
    k_nope, v_m = kv[..., :MLA_NOPE_DIM], kv[..., MLA_NOPE_DIM:]
    k_rope = rope(proj[..., OFF_KR:IN_W])
    o_mla = mla_attention(q_nope, q_rope, k_nope, k_rope, v_m)
    mix = jnp.concatenate([rmsnorm(o_swa, g_swa_out), rmsnorm(o_mla, g_mla_out)], axis=-1) @ w_o
    h = h + mix
    n2 = rmsnorm(h, g_ffn)
    h = h + (jax.nn.silu(n2 @ w_ffn_gate) * (n2 @ w_ffn_up)) @ w_ffn_down
    gate = jax.nn.sigmoid(rmsnorm(h, g_ple) @ w_ple_gate)
    h = h + gate * (p_i @ w_ple_proj)
    return h


def encoder(x, p, g_mix, w_in, g_cq, w_uq, g_ckv, w_ukv, sink, g_swa_out, g_mla_out, w_o,
            g_ffn, w_ffn_gate, w_ffn_up, w_ffn_down, g_ple, w_ple_gate, w_ple_proj, g_final):
    h = x
    for i in range(DEPTH):
        h = encoder_layer(h, p[i], g_mix[i], w_in[i], g_cq[i], w_uq[i], g_ckv[i], w_ukv[i], sink[i],
                          g_swa_out[i], g_mla_out[i], w_o[i], g_ffn[i], w_ffn_gate[i], w_ffn_up[i],
                          w_ffn_down[i], g_ple[i], w_ple_gate[i], w_ple_proj[i])
    return rmsnorm(h, g_final)


def setup_inputs(seed: int = 0) -> dict:
    key = jax.random.key(seed)
    ks = jax.random.split(key, 24)
    f32 = jnp.float32

    def w(k, shape, fan_in):
        return jax.random.normal(k, shape, f32) * (fan_in ** -0.5)

    def g(k, shape):
        return 1.0 + 0.01 * jax.random.normal(k, shape, f32)

    L = DEPTH
    return {
        "x_prompt": jax.random.normal(ks[0], (BATCH, SEQ, D_MODEL), f32),
        "x_sample": jax.random.normal(ks[1], (DEC_BATCH, DEC_SEQ, D_MODEL), f32),
        "p_prompt": jax.random.normal(ks[2], (DEPTH, BATCH, SEQ, PLE_DIM), f32),
        "p_sample": jax.random.normal(ks[3], (DEPTH, DEC_BATCH, DEC_SEQ, PLE_DIM), f32),
        "g_mix": g(ks[4], (L, D_MODEL)),
        "w_in": w(ks[5], (L, D_MODEL, IN_W), D_MODEL),
        "g_cq": g(ks[6], (L, MLA_Q_RANK)),
        "w_uq": w(ks[7], (L, MLA_Q_RANK, MLA_HEADS * (MLA_NOPE_DIM + MLA_ROPE_DIM)), MLA_Q_RANK),
        "g_ckv": g(ks[8], (L, MLA_KV_RANK)),
        "w_ukv": w(ks[9], (L, MLA_KV_RANK, MLA_HEADS * (MLA_NOPE_DIM + MLA_V_DIM)), MLA_KV_RANK),
        "sink": 0.5 * jax.random.normal(ks[10], (L, SWA_HEADS), f32),
        "g_swa_out": g(ks[11], (L, SWA_OUT_W)),
        "g_mla_out": g(ks[12], (L, MLA_OUT_W)),
        "w_o": w(ks[13], (L, MIX_W, D_MODEL), MIX_W),
        "g_ffn": g(ks[14], (L, D_MODEL)),
        "w_ffn_gate": w(ks[15], (L, D_MODEL, D_FF), D_MODEL),
        "w_ffn_up": w(ks[16], (L, D_MODEL, D_FF), D_MODEL),
        "w_ffn_down": w(ks[17], (L, D_FF, D_MODEL), D_FF),
        "g_ple": g(ks[18], (L, D_MODEL)),
        "w_ple_gate": w(ks[19], (L, D_MODEL, D_MODEL), D_MODEL),
        "w_ple_proj": w(ks[20], (L, PLE_DIM, D_MODEL), PLE_DIM),
        "g_final": g(ks[21], (D_MODEL,)),
    }


def reference(x_prompt, x_sample, p_prompt, p_sample, g_mix, w_in, g_cq, w_uq, g_ckv, w_ukv, sink,
              g_swa_out, g_mla_out, w_o, g_ffn, w_ffn_gate, w_ffn_up, w_ffn_down, g_ple, w_ple_gate,
              w_ple_proj, g_final):
    y_prompt = encoder(x_prompt, p_prompt, g_mix, w_in, g_cq, w_uq, g_ckv, w_ukv, sink, g_swa_out,
                       g_mla_out, w_o, g_ffn, w_ffn_gate, w_ffn_up, w_ffn_down, g_ple, w_ple_gate,
                       w_ple_proj, g_final)
    y_sample = encoder(x_sample, p_sample, g_mix, w_in, g_cq, w_uq, g_ckv, w_ukv, sink, g_swa_out,
                       g_mla_out, w_o, g_ffn, w_ffn_gate, w_ffn_up, w_ffn_down, g_ple, w_ple_gate,
                       w_ple_proj, g_final)
    return (y_prompt, y_sample)
```

```cpp
#include <hip/hip_runtime.h>
#include <hip/hip_cooperative_groups.h>
#include <cstdio>
#include <cstdint>
namespace cg = cooperative_groups;

#ifndef MULTI_LAUNCH
#define MULTI_LAUNCH 0
#endif

typedef unsigned short bf16_t;
typedef short bf16x8 __attribute__((ext_vector_type(8)));
typedef float f32x2 __attribute__((ext_vector_type(2)));
typedef float f32x4 __attribute__((ext_vector_type(4)));
typedef float f32x16 __attribute__((ext_vector_type(16)));
typedef unsigned u32x2 __attribute__((ext_vector_type(2)));
typedef unsigned u32x4 __attribute__((ext_vector_type(4)));
typedef __bf16 hbf16x2 __attribute__((ext_vector_type(2)));

#define DI __device__ __forceinline__

constexpr int T = 65536, TP = 32768;
constexpr float EPS = 1e-6f;
constexpr float LOG2E = 1.4426950408889634f;
constexpr float QSCALE_SWA = 0.125f * LOG2E;
constexpr float QSCALE_MLA = 0.10206207261596577f * LOG2E;
constexpr int NPHASE = 10;

struct KArgs { const float* in[22]; float* out; unsigned char* ws; int ph_lo, ph_hi; };

struct Params {
    const float *x_p, *x_s, *p_p, *p_s;
    const float *g_mix, *w_in, *g_cq, *w_uq, *g_ckv, *w_ukv, *sink, *g_swa, *g_mla, *w_o, *g_ffn, *w_gate, *w_up, *w_down, *g_ple, *w_pg, *w_pp, *g_final;
    float* out;
    bf16_t *wt_in, *wt_uq, *wt_ukv, *wt_o, *wt_gu, *wt_d, *wt_pg, *wt_pp;
    float *rx, *rs_cq, *rs_ckv, *rs_oswa, *rs_omla, *rs_h1, *rs_h2, *rs_h3;
    f32x2* rope;
    bf16_t *xb, *cq, *ckv, *qm;
    bf16_t *o, *qs, *ks, *vst, *kr, *km, *vmt, *hb, *act, *pb;
};

DI Params make_params(const KArgs& a) {
    Params p;
    const float* const* in = a.in;
    p.x_p = in[0]; p.x_s = in[1]; p.p_p = in[2]; p.p_s = in[3];
    p.g_mix = in[4]; p.w_in = in[5]; p.g_cq = in[6]; p.w_uq = in[7]; p.g_ckv = in[8]; p.w_ukv = in[9]; p.sink = in[10];
    p.g_swa = in[11]; p.g_mla = in[12]; p.w_o = in[13]; p.g_ffn = in[14]; p.w_gate = in[15]; p.w_up = in[16]; p.w_down = in[17];
    p.g_ple = in[18]; p.w_pg = in[19]; p.w_pp = in[20]; p.g_final = in[21];
    p.out = a.out;
    unsigned char* ws = a.ws; unsigned char* ob = (unsigned char*)a.out;
    constexpr size_t MB = (size_t)1 << 20;
    size_t off = 0;
    p.wt_in = (bf16_t*)(ws + off); off += (size_t)1280 * 1024 * 2;
    p.wt_uq = (bf16_t*)(ws + off); off += (size_t)768 * 256 * 2;
    p.wt_ukv = (bf16_t*)(ws + off); off += (size_t)1024 * 128 * 2;
    p.wt_o = (bf16_t*)(ws + off); off += (size_t)1024 * 1024 * 2;
    p.wt_gu = (bf16_t*)(ws + off); off += (size_t)5632 * 1024 * 2;
    p.wt_d = (bf16_t*)(ws + off); off += (size_t)1024 * 2816 * 2;
    p.wt_pg = (bf16_t*)(ws + off); off += (size_t)1024 * 1024 * 2;
    p.wt_pp = (bf16_t*)(ws + off); off += (size_t)1024 * 256 * 2;
    float* misc = (float*)(ws + 25 * MB);
    p.rx = misc; p.rs_cq = misc + T; p.rs_ckv = misc + 2 * T; p.rs_oswa = misc + 3 * T; p.rs_omla = misc + 4 * T; p.rs_h1 = misc + 5 * T; p.rs_h2 = misc + 6 * T; p.rs_h3 = misc + 7 * T;
    p.rope = (f32x2*)(ws + 27 * MB);
    p.o = (bf16_t*)(ws + 32 * MB); p.qs = (bf16_t*)(ws + 160 * MB); p.ks = (bf16_t*)(ws + 224 * MB); p.vst = (bf16_t*)(ws + 240 * MB);
    p.kr = (bf16_t*)(ws + 256 * MB); p.km = (bf16_t*)(ws + 264 * MB); p.vmt = (bf16_t*)(ws + 328 * MB);
    p.hb = (bf16_t*)(ws + 384 * MB); p.act = (bf16_t*)(ws + 32 * MB); p.pb = (bf16_t*)(ws + 32 * MB);
    p.xb = (bf16_t*)(ob); p.cq = (bf16_t*)(ob + 128 * MB); p.ckv = (bf16_t*)(ob + 160 * MB); p.qm = (bf16_t*)(ob);
    return p;
}

DI unsigned cvt_pk(float lo, float hi) {
    f32x2 v = {lo, hi};
    hbf16x2 b = __builtin_convertvector(v, hbf16x2);
    return __builtin_bit_cast(unsigned, b);
}
DI void st_bf16x4(bf16_t* p, f32x4 v) { u32x2 w; w.x = cvt_pk(v[0], v[1]); w.y = cvt_pk(v[2], v[3]); *(u32x2*)p = w; }
DI bf16_t f2bf(float x) { unsigned u = __float_as_uint(x); u += 0x7fffu + ((u >> 16) & 1u); return (bf16_t)(u >> 16); }
DI void glds16(const void* g, void* l) { __builtin_amdgcn_global_load_lds((const unsigned*)g, (__attribute__((address_space(3))) unsigned*)l, 16, 0, 0); }
DI float fexp2(float x) { return __builtin_amdgcn_exp2f(x); }
DI void atomic_addf(float* p, float v) { unsafeAtomicAdd(p, v); }

DI void stage128(const bf16_t* g, int ld, unsigned char* lt, int tid) {
    const int pc = tid & 7, ch = pc ^ ((tid >> 4) & 7);
#pragma unroll
    for (int rr = 0; rr < 4; ++rr) {
        const int row = rr * 32 + (tid >> 3);
        glds16(g + (size_t)row * ld + ch * 8, lt + rr * 4096 + tid * 16);
    }
}

DI void gemm_kloop(f32x4 (&acc)[4][4], const bf16_t* Ag, int lda, const bf16_t* Bg, int ldb, int nk, unsigned char* smem, int tid) {
    const int wid = tid >> 6, lane = tid & 63, wr = wid >> 1, wc = wid & 1, fr = lane & 15, fq = lane >> 4;
    stage128(Ag, lda, smem, tid);
    stage128(Bg, ldb, smem + 16384, tid);
    const int sw = fr >> 1;
#pragma unroll 1
    for (int t = 0; t < nk; ++t) {
        asm volatile("s_waitcnt vmcnt(0)" ::: "memory");
        __syncthreads();
        if (t + 1 < nk) {
            unsigned char* nb = smem + ((t + 1) & 1) * 32768;
            stage128(Ag + (t + 1) * 64, lda, nb, tid);
            stage128(Bg + (t + 1) * 64, ldb, nb + 16384, tid);
        }
        const unsigned char* sa = smem + (t & 1) * 32768 + (wr * 64 + fr) * 128;
        const unsigned char* sb = smem + (t & 1) * 32768 + 16384 + (wc * 64 + fr) * 128;
#pragma unroll
        for (int kk = 0; kk < 2; ++kk) {
            const int co = ((kk * 4 + fq) ^ sw) * 16;
            bf16x8 a[4], b[4];
#pragma unroll
            for (int m = 0; m < 4; ++m) a[m] = *(const bf16x8*)(sa + m * 2048 + co);
#pragma unroll
            for (int n = 0; n < 4; ++n) b[n] = *(const bf16x8*)(sb + n * 2048 + co);
#pragma unroll
            for (int m = 0; m < 4; ++m)
#pragma unroll
                for (int n = 0; n < 4; ++n) acc[m][n] = __builtin_amdgcn_mfma_f32_16x16x32_bf16(b[n], a[m], acc[m][n], 0, 0, 0);
        }
    }
    __syncthreads();
}

DI void tile_decode(int L, int nN, int& pm, int& pn) {
    const int q = (512 * nN) >> 3, xcd = L & 7, off = L >> 3;
    const int wgid = xcd * q + off, nig = 8 * nN, gid = wgid / nig, rem = wgid % nig;
    pm = gid * 8 + (rem & 7); pn = rem >> 3;
}

DI void zero_acc(f32x4 (&acc)[4][4]) {
#pragma unroll
    for (int m = 0; m < 4; ++m)
#pragma unroll
        for (int n = 0; n < 4; ++n) acc[m][n] = (f32x4){0.f, 0.f, 0.f, 0.f};
}

DI float row_sumsq_reduce(float s) { s += __shfl_xor(s, 16); s += __shfl_xor(s, 32); return s; }

DI void prep_tile(const float* src, const float* src_alt, int Nsrc, const float* gain, const float* gain_hi, bf16_t* dst, int K, int mode,
                  int kt, int nt, float* tl, int tid) {
    const int k0 = kt * 64, n0 = nt * 64, tx = tid & 63, ty = tid >> 6;
    const int n = n0 + tx;
    const float* s = src; int sc = n; bool valid = true;
    if (mode == 1) {
        const int tile = n >> 7, within = n & 127, wc = within >> 6, w64 = within & 63;
        sc = tile * 64 + wc * 32 + (w64 & 31); s = (w64 >> 5) ? src_alt : src;
    } else valid = n < Nsrc;
    for (int i = ty; i < 64; i += 4) {
        const int k = k0 + i;
        float v = valid ? s[(size_t)k * Nsrc + sc] : 0.f;
        float g = 1.f;
        if (gain) g = (gain_hi && k >= 512) ? gain_hi[k - 512] : gain[k];
        tl[i * 65 + tx] = v * g;
    }
    __syncthreads();
    const int r = tid >> 2, kc = (tid & 3) * 16;
    u32x4 w0, w1;
    w0.x = cvt_pk(tl[(kc + 0) * 65 + r], tl[(kc + 1) * 65 + r]); w0.y = cvt_pk(tl[(kc + 2) * 65 + r], tl[(kc + 3) * 65 + r]);
    w0.z = cvt_pk(tl[(kc + 4) * 65 + r], tl[(kc + 5) * 65 + r]); w0.w = cvt_pk(tl[(kc + 6) * 65 + r], tl[(kc + 7) * 65 + r]);
    w1.x = cvt_pk(tl[(kc + 8) * 65 + r], tl[(kc + 9) * 65 + r]); w1.y = cvt_pk(tl[(kc + 10) * 65 + r], tl[(kc + 11) * 65 + r]);
    w1.z = cvt_pk(tl[(kc + 12) * 65 + r], tl[(kc + 13) * 65 + r]); w1.w = cvt_pk(tl[(kc + 14) * 65 + r], tl[(kc + 15) * 65 + r]);
    bf16_t* d = dst + (size_t)(n0 + r) * K + k0 + kc;
    *(u32x4*)d = w0; *(u32x4*)(d + 8) = w1;
    __syncthreads();
}

__device__ void phase0(const Params& p, unsigned char* smem, int tid) {
    float* tl = (float*)smem;
    constexpr int C0 = 320, C1 = C0 + 48, C2 = C1 + 32, C3 = C2 + 256, C4 = C3 + 1408, C5 = C4 + 704, C6 = C5 + 256, C7 = C6 + 64;
    for (int i = blockIdx.x; i < C7; i += gridDim.x) {
        if (i < C0)      { const int j = i;      prep_tile(p.w_in, nullptr, 1184, p.g_mix, nullptr, p.wt_in, 1024, 0, j % 16, j / 16, tl, tid); }
        else if (i < C1) { const int j = i - C0; prep_tile(p.w_uq, nullptr, 768, p.g_cq, nullptr, p.wt_uq, 256, 0, j % 4, j / 4, tl, tid); }
        else if (i < C2) { const int j = i - C1; prep_tile(p.w_ukv, nullptr, 1024, p.g_ckv, nullptr, p.wt_ukv, 128, 0, j % 2, j / 2, tl, tid); }
        else if (i < C3) { const int j = i - C2; prep_tile(p.w_o, nullptr, 1024, p.g_swa, p.g_mla, p.wt_o, 1024, 0, j % 16, j / 16, tl, tid); }
        else if (i < C4) { const int j = i - C3; prep_tile(p.w_gate, p.w_up, 2816, p.g_ffn, nullptr, p.wt_gu, 1024, 1, j % 16, j / 16, tl, tid); }
        else if (i < C5) { const int j = i - C4; prep_tile(p.w_down, nullptr, 1024, nullptr, nullptr, p.wt_d, 2816, 0, j % 44, j / 44, tl, tid); }
        else if (i < C6) { const int j = i - C5; prep_tile(p.w_pg, nullptr, 1024, p.g_ple, nullptr, p.wt_pg, 1024, 0, j % 16, j / 16, tl, tid); }
        else             { const int j = i - C6; prep_tile(p.w_pp, nullptr, 1024, nullptr, nullptr, p.wt_pp, 256, 0, j % 4, j / 4, tl, tid); }
    }
    const int lane = tid & 63, gw = blockIdx.x * 4 + (tid >> 6), nw = gridDim.x * 4;
    for (int row = gw; row < T; row += nw) {
        const float* xr = row < TP ? p.x_p + (size_t)row * 1024 : p.x_s + (size_t)(row - TP) * 1024;
        f32x4 v[4]; float ss = 0.f;
#pragma unroll
        for (int i = 0; i < 4; ++i) { v[i] = *(const f32x4*)(xr + (i * 64 + lane) * 4); ss += v[i][0] * v[i][0] + v[i][1] * v[i][1] + v[i][2] * v[i][2] + v[i][3] * v[i][3]; }
#pragma unroll
        for (int o = 32; o >= 1; o >>= 1) ss += __shfl_xor(ss, o);
        if (lane == 0) p.rx[row] = 1.0f / sqrtf(ss * (1.0f / 1024.0f) + EPS);
#pragma unroll
        for (int i = 0; i < 4; ++i) st_bf16x4(p.xb + (size_t)row * 1024 + (i * 64 + lane) * 4, v[i]);
    }
    const int gt = blockIdx.x * 256 + tid, nt = gridDim.x * 256;
    for (int idx = gt; idx < 16384 * 16; idx += nt) {
        const int s = idx >> 4, i = idx & 15;
        const float inv = (float)pow(10000.0, -(double)i / 16.0);
        const float ang = (float)s * inv;
        const double a = (double)ang;
        p.rope[idx] = (f32x2){(float)cos(a), (float)sin(a)};
    }
    for (int idx = gt; idx < 7 * T; idx += nt) p.rs_cq[idx] = 0.f;
}

DI void seq_of_row(int row, int& S, int& s) { if (row < TP) { S = 16384; s = row & 16383; } else { S = 4096; s = row & 4095; } }

__device__ void phase1(const Params& p, unsigned char* smem, int tid) {
    const int wid = tid >> 6, lane = tid & 63, wr = wid >> 1, wc = wid & 1, fr = lane & 15, fq = lane >> 4;
    for (int L = blockIdx.x; L < 512 * 10; L += gridDim.x) {
        int pm, pn; tile_decode(L, 10, pm, pn);
        f32x4 acc[4][4]; zero_acc(acc);
        gemm_kloop(acc, p.xb + (size_t)pm * 128 * 1024, 1024, p.wt_in + (size_t)pn * 128 * 1024, 1024, 16, smem, tid);
#pragma unroll
        for (int m = 0; m < 4; ++m) {
            const int row = pm * 128 + wr * 64 + m * 16 + fr;
            const float r = p.rx[row];
            int S, s; seq_of_row(row, S, s);
            const int ct = wc * 64 + 4 * fq;
            if (pn < 4) {
#pragma unroll
                for (int n = 0; n < 4; ++n) st_bf16x4(p.qs + (size_t)row * 512 + pn * 128 + ct + n * 16, acc[m][n] * (r * QSCALE_SWA));
            } else if (pn == 4) {
#pragma unroll
                for (int n = 0; n < 4; ++n) st_bf16x4(p.ks + (size_t)row * 128 + ct + n * 16, acc[m][n] * r);
            } else if (pn == 5) {
                bf16_t* vb = p.vst + (size_t)(row - s) * 128 + s;
#pragma unroll
                for (int n = 0; n < 4; ++n)
#pragma unroll
                    for (int j = 0; j < 4; ++j) vb[(size_t)(ct + n * 16 + j) * S] = f2bf(acc[m][n][j] * r);
            } else if (pn < 8) {
                float ss = 0.f;
#pragma unroll
                for (int n = 0; n < 4; ++n) { f32x4 v = acc[m][n] * r; ss += v[0] * v[0] + v[1] * v[1] + v[2] * v[2] + v[3] * v[3]; st_bf16x4(p.cq + (size_t)row * 256 + (pn - 6) * 128 + ct + n * 16, v); }
                ss = row_sumsq_reduce(ss);
                if (fq == 0) atomic_addf(p.rs_cq + row, ss);
            } else if (pn == 8) {
                float ss = 0.f;
#pragma unroll
                for (int n = 0; n < 4; ++n) { f32x4 v = acc[m][n] * r; ss += v[0] * v[0] + v[1] * v[1] + v[2] * v[2] + v[3] * v[3]; st_bf16x4(p.ckv + (size_t)row * 128 + ct + n * 16, v); }
                ss = row_sumsq_reduce(ss);
                if (fq == 0) atomic_addf(p.rs_ckv + row, ss);
            } else if (wc == 0) {
                f32x4 x1 = acc[m][0] * r, x2 = acc[m][1] * r, o1, o2;
#pragma unroll
                for (int j = 0; j < 4; ++j) { const f32x2 cs = p.rope[s * 16 + 4 * fq + j]; o1[j] = x1[j] * cs.x - x2[j] * cs.y; o2[j] = x2[j] * cs.x + x1[j] * cs.y; }
                st_bf16x4(p.kr + (size_t)row * 32 + 4 * fq, o1);
                st_bf16x4(p.kr + (size_t)row * 32 + 16 + 4 * fq, o2);
            }
        }
    }
}

__device__ void phase2(const Params& p, unsigned char* smem, int tid) {
    const int wid = tid >> 6, lane = tid & 63, wr = wid >> 1, wc = wid & 1, fr = lane & 15, fq = lane >> 4;
    for (int L = blockIdx.x; L < 512 * 14; L += gridDim.x) {
        if (L < 512 * 6) {
            int pm, pn; tile_decode(L, 6, pm, pn);
            f32x4 acc[4][4]; zero_acc(acc);
            gemm_kloop(acc, p.cq + (size_t)pm * 128 * 256, 256, p.wt_uq + (size_t)pn * 128 * 256, 256, 4, smem, tid);
            const int cb = pn * 128 + wc * 64;
#pragma unroll
            for (int m = 0; m < 4; ++m) {
                const int row = pm * 128 + wr * 64 + m * 16 + fr;
                const float r = QSCALE_MLA / sqrtf(p.rs_cq[row] * (1.0f / 256.0f) + EPS);
                int S, s; seq_of_row(row, S, s);
#pragma unroll
                for (int n = 0; n < 4; n += 2) {
                    const int c0 = cb + n * 16;
                    f32x4 x1 = acc[m][n] * r, x2 = acc[m][n + 1] * r;
                    if (((c0 >> 5) % 3) == 2) {
                        f32x4 o1, o2;
#pragma unroll
                        for (int j = 0; j < 4; ++j) { const f32x2 cs = p.rope[s * 16 + 4 * fq + j]; o1[j] = x1[j] * cs.x - x2[j] * cs.y; o2[j] = x2[j] * cs.x + x1[j] * cs.y; }
                        x1 = o1; x2 = o2;
                    }
                    st_bf16x4(p.qm + (size_t)row * 768 + c0 + 4 * fq, x1);
                    st_bf16x4(p.qm + (size_t)row * 768 + c0 + 16 + 4 * fq, x2);
                }
            }
        } else {
            int pm, pn; tile_decode(L - 512 * 6, 8, pm, pn);
            f32x4 acc[4][4]; zero_acc(acc);
            gemm_kloop(acc, p.ckv + (size_t)pm * 128 * 128, 128, p.wt_ukv + (size_t)pn * 128 * 128, 128, 2, smem, tid);
#pragma unroll
            for (int m = 0; m < 4; ++m) {
                const int row = pm * 128 + wr * 64 + m * 16 + fr;
                const float r = 1.0f / sqrtf(p.rs_ckv[row] * (1.0f / 128.0f) + EPS);
                int S, s; seq_of_row(row, S, s);
                if (wc == 0) {
#pragma unroll
                    for (int n = 0; n < 4; ++n) st_bf16x4(p.km + (size_t)row * 512 + pn * 64 + n * 16 + 4 * fq, acc[m][n] * r);
                } else {
                    bf16_t* vb = p.vmt + (size_t)(row - s) * 512 + (size_t)pn * 64 * S + s;
#pragma unroll
                    for (int n = 0; n < 4; ++n)
#pragma unroll
                        for (int j = 0; j < 4; ++j) vb[(size_t)(n * 16 + 4 * fq + j) * S] = f2bf(acc[m][n][j] * r);
                }
            }
        }
    }
}

DI bf16x8 pack8(const f32x16& x, int s8) {
    u32x4 w;
    w.x = cvt_pk(x[s8 + 0], x[s8 + 1]); w.y = cvt_pk(x[s8 + 2], x[s8 + 3]); w.z = cvt_pk(x[s8 + 4], x[s8 + 5]); w.w = cvt_pk(x[s8 + 6], x[s8 + 7]);
    return __builtin_bit_cast(bf16x8, w);
}

template <bool SWA>
DI void attn_item(const Params& p, unsigned char* smem, int tid, int tok0, int S, int head, int qb) {
    constexpr int NQ = SWA ? 4 : 6;
    constexpr int STG = 20480;
    const int w = tid >> 6, lane = tid & 63, r = lane & 31, h = lane >> 5;
    const int krow = (r & 3) | ((r & 4) << 1) | ((r & 8) >> 1) | (r & 16);
    const int kswz = (krow >> 1) & 7, krswz = (krow >> 2) & 3, vswz = (r >> 1) & 7;
    const int qpos = qb * 128 + w * 32 + r;
    const int q_tok = tok0 + qpos;
    bf16x8 qf[NQ];
    {
        const bf16_t* qptr = SWA ? p.qs + (size_t)q_tok * 512 + head * 64 : p.qm + (size_t)q_tok * 768 + head * 96;
#pragma unroll
        for (int ks = 0; ks < NQ; ++ks) qf[ks] = *(const bf16x8*)(qptr + ks * 16 + h * 8);
    }
    const int ldk = SWA ? 128 : 512;
    const bf16_t* kn_base = SWA ? p.ks + (size_t)tok0 * 128 + (head >> 2) * 64 : p.km + (size_t)tok0 * 512 + head * 64;
    const bf16_t* kr_base = p.kr + (size_t)tok0 * 32;
    const bf16_t* vt_base = SWA ? p.vst + (size_t)tok0 * 128 + (size_t)(head >> 2) * 64 * S : p.vmt + (size_t)tok0 * 512 + (size_t)head * 64 * S;
    int kt0 = 0, kt1 = S >> 6;
    if (SWA) { int lo = qb * 128 - 128, hi = qb * 128 + 256; lo = lo < 0 ? 0 : lo; hi = hi > S ? S : hi; kt0 = lo >> 6; kt1 = hi >> 6; }
    float slope2 = 0.f, mrun = -1e30f, lrun = 0.f;
    if (SWA) { slope2 = exp2f(-(float)(head + 1)) * LOG2E; mrun = p.sink[head] * LOG2E; lrun = h == 0 ? 1.f : 0.f; }

    f32x16 o0, o1;
#pragma unroll
    for (int i = 0; i < 16; ++i) { o0[i] = 0.f; o1[i] = 0.f; }

    auto stage = [&](int kt, int buf) {
        unsigned char* sb = smem + buf * STG;
        const int key0 = kt * 64;
        const int pc = tid & 7, ch = pc ^ ((tid >> 4) & 7);
#pragma unroll
        for (int rr = 0; rr < 2; ++rr) {
            const int row = rr * 32 + (tid >> 3);
            glds16(kn_base + (size_t)(key0 + row) * ldk + ch * 8, sb + rr * 4096 + tid * 16);
            glds16(vt_base + (size_t)row * S + key0 + ch * 8, sb + 8192 + rr * 4096 + tid * 16);
        }
        if (!SWA) {
            const int row = tid >> 2, c4 = (tid & 3) ^ ((row >> 2) & 3);
            glds16(kr_base + (size_t)(key0 + row) * 32 + c4 * 8, sb + 16384 + tid * 16);
        }
    };

    stage(kt0, 0);
    for (int kt = kt0; kt < kt1; ++kt) {
        const int buf = (kt - kt0) & 1;
        asm volatile("s_waitcnt vmcnt(0)" ::: "memory");
        __syncthreads();
        if (kt + 1 < kt1) stage(kt + 1, buf ^ 1);
        const int key0 = kt * 64;
        bool active = true;
        if (SWA) { const int q0w = qb * 128 + w * 32; active = !(key0 > q0w + 31 + 128 || key0 + 63 < q0w - 128); }
        if (active) {
            const unsigned char* sb = smem + buf * STG;
            f32x16 s0, s1;
#pragma unroll
            for (int i = 0; i < 16; ++i) { s0[i] = 0.f; s1[i] = 0.f; }
#pragma unroll
            for (int ks = 0; ks < 4; ++ks) {
                const int co = ((2 * ks + h) ^ kswz) * 16;
                const bf16x8 a0 = *(const bf16x8*)(sb + krow * 128 + co);
                const bf16x8 a1 = *(const bf16x8*)(sb + (32 + krow) * 128 + co);
                s0 = __builtin_amdgcn_mfma_f32_32x32x16_bf16(a0, qf[ks], s0, 0, 0, 0);
                s1 = __builtin_amdgcn_mfma_f32_32x32x16_bf16(a1, qf[ks], s1, 0, 0, 0);
            }
            if (!SWA) {
#pragma unroll
                for (int ks = 0; ks < 2; ++ks) {
                    const int co = ((2 * ks + h) ^ krswz) * 16;
                    const bf16x8 a0 = *(const bf16x8*)(sb + 16384 + krow * 64 + co);
                    const bf16x8 a1 = *(const bf16x8*)(sb + 16384 + (32 + krow) * 64 + co);
                    s0 = __builtin_amdgcn_mfma_f32_32x32x16_bf16(a0, qf[NQ - 2 + ks], s0, 0, 0, 0);
                    s1 = __builtin_amdgcn_mfma_f32_32x32x16_bf16(a1, qf[NQ - 2 + ks], s1, 0, 0, 0);
                }
            }
            if (SWA) {
#pragma unroll
                for (int i = 0; i < 16; ++i) {
                    const int kidx = (i & 3) + 4 * ((i >> 2) & 1) + 8 * h + 16 * ((i >> 3) & 1);
                    const int d0 = key0 + kidx - qpos, d1 = d0 + 32;
                    const int a0 = d0 < 0 ? -d0 : d0, a1 = d1 < 0 ? -d1 : d1;
                    s0[i] = a0 <= 128 ? s0[i] - slope2 * (float)a0 : -1e30f;
                    s1[i] = a1 <= 128 ? s1[i] - slope2 * (float)a1 : -1e30f;
                }
            }
            float mx = fmaxf(s0[0], s1[0]);
#pragma unroll
            for (int i = 1; i < 16; ++i) mx = fmaxf(fmaxf(mx, s0[i]), s1[i]);
            mx = fmaxf(mx, __shfl_xor(mx, 32));
            if (__any(mx > mrun + 6.0f)) {
                const float mnew = fmaxf(mrun, mx);
                const float alpha = fexp2(mrun - mnew);
                mrun = mnew; lrun *= alpha;
#pragma unroll
                for (int i = 0; i < 16; ++i) { o0[i] *= alpha; o1[i] *= alpha; }
            }
            float ps = 0.f;
#pragma unroll
            for (int i = 0; i < 16; ++i) { s0[i] = fexp2(s0[i] - mrun); s1[i] = fexp2(s1[i] - mrun); ps += s0[i] + s1[i]; }
            lrun += ps;
            const unsigned char* sv = sb + 8192 + r * 128;
#pragma unroll
            for (int blk = 0; blk < 2; ++blk)
#pragma unroll
                for (int s = 0; s < 2; ++s) {
                    const bf16x8 pf = pack8(blk ? s1 : s0, 8 * s);
                    const int co = ((4 * blk + 2 * s + h) ^ vswz) * 16;
                    const bf16x8 v0 = *(const bf16x8*)(sv + co);
                    const bf16x8 v1 = *(const bf16x8*)(sv + 32 * 128 + co);
                    o0 = __builtin_amdgcn_mfma_f32_32x32x16_bf16(v0, pf, o0, 0, 0, 0);
                    o1 = __builtin_amdgcn_mfma_f32_32x32x16_bf16(v1, pf, o1, 0, 0, 0);
                }
        }
    }
    const float l = lrun + __shfl_xor(lrun, 32);
    const float inv = 1.0f / l;
    bf16_t* orow = p.o + (size_t)q_tok * 1024 + (SWA ? 0 : 512) + head * 64;
    float ss = 0.f;
#pragma unroll
    for (int g = 0; g < 4; ++g) {
        f32x4 v0 = {o0[4 * g] * inv, o0[4 * g + 1] * inv, o0[4 * g + 2] * inv, o0[4 * g + 3] * inv};
        f32x4 v1 = {o1[4 * g] * inv, o1[4 * g + 1] * inv, o1[4 * g + 2] * inv, o1[4 * g + 3] * inv};
        ss += v0[0] * v0[0] + v0[1] * v0[1] + v0[2] * v0[2] + v0[3] * v0[3] + v1[0] * v1[0] + v1[1] * v1[1] + v1[2] * v1[2] + v1[3] * v1[3];
        st_bf16x4(orow + 8 * g + 4 * h, v0);
        st_bf16x4(orow + 32 + 8 * g + 4 * h, v1);
    }
    ss += __shfl_xor(ss, 32);
    if (h == 0) atomic_addf((SWA ? p.rs_oswa : p.rs_omla) + q_tok, ss);
    __syncthreads();
}

__device__ void phase3(const Params& p, unsigned char* smem, int tid) {
    for (int I = blockIdx.x; I < 8192; I += gridDim.x) {
        if (I < 2048) {
            const int rnd = I >> 9, B = I & 511, xcd = B & 7, slot = B >> 3;
            const int combo = xcd + 8 * (rnd >> 1), qb = (rnd & 1) * 64 + slot;
            attn_item<false>(p, smem, tid, (combo >> 3) * 16384, 16384, combo & 7, qb);
        } else if (I < 4096) {
            const int J = I - 2048, rnd = J >> 9, B = J & 511, xcd = B & 7, slot = B >> 3;
            const int combo = xcd * 8 + rnd * 2 + (slot >> 5), qb = slot & 31;
            attn_item<false>(p, smem, tid, TP + (combo >> 3) * 4096, 4096, combo & 7, qb);
        } else {
            const int J = I - 4096, head = J >> 9, tb = (J & 511) * 128;
            int tok0, S;
            if (tb < TP) { tok0 = (tb >> 14) << 14; S = 16384; } else { tok0 = TP + (((tb - TP) >> 12) << 12); S = 4096; }
            attn_item<true>(p, smem, tid, tok0, S, head, (tb - tok0) >> 7);
        }
    }
}

__device__ void phase4(const Params& p, unsigned char* smem, int tid) {
    const int wid = tid >> 6, lane = tid & 63, wr = wid >> 1, wc = wid & 1, fr = lane & 15, fq = lane >> 4;
    for (int L = blockIdx.x; L < 512 * 8; L += gridDim.x) {
        int pm, pn; tile_decode(L, 8, pm, pn);
        f32x4 acc[4][4]; zero_acc(acc);
        const bf16_t* A = p.o + (size_t)pm * 128 * 1024; const bf16_t* B = p.wt_o + (size_t)pn * 128 * 1024;
        gemm_kloop(acc, A, 1024, B, 1024, 8, smem, tid);
        float rm[4];
#pragma unroll
        for (int m = 0; m < 4; ++m) {
            const int row = pm * 128 + wr * 64 + m * 16 + fr;
            const float rs = 1.0f / sqrtf(p.rs_oswa[row] * (1.0f / 512.0f) + EPS);
            rm[m] = 1.0f / sqrtf(p.rs_omla[row] * (1.0f / 512.0f) + EPS);
            const float f = rs / rm[m];
#pragma unroll
            for (int n = 0; n < 4; ++n) acc[m][n] *= f;
        }
        gemm_kloop(acc, A + 512, 1024, B + 512, 1024, 8, smem, tid);
#pragma unroll
        for (int m = 0; m < 4; ++m) {
            const int row = pm * 128 + wr * 64 + m * 16 + fr;
            const float* xr = row < TP ? p.x_p + (size_t)row * 1024 : p.x_s + (size_t)(row - TP) * 1024;
            float ss = 0.f;
#pragma unroll
            for (int n = 0; n < 4; ++n) {
                const int col = pn * 128 + wc * 64 + n * 16 + 4 * fq;
                const f32x4 hv = *(const f32x4*)(xr + col) + acc[m][n] * rm[m];
                ss += hv[0] * hv[0] + hv[1] * hv[1] + hv[2] * hv[2] + hv[3] * hv[3];
                *(f32x4*)(p.out + (size_t)row * 1024 + col) = hv;
                st_bf16x4(p.hb + (size_t)row * 1024 + col, hv);
            }
            ss = row_sumsq_reduce(ss);
            if (fq == 0) atomic_addf(p.rs_h1 + row, ss);
        }
    }
}

__device__ void phase5(const Params& p, unsigned char* smem, int tid) {
    const int wid = tid >> 6, lane = tid & 63, wr = wid >> 1, wc = wid & 1, fr = lane & 15, fq = lane >> 4;
    for (int L = blockIdx.x; L < 512 * 44; L += gridDim.x) {
        int pm, pn; tile_decode(L, 44, pm, pn);
        f32x4 acc[4][4]; zero_acc(acc);
        gemm_kloop(acc, p.hb + (size_t)pm * 128 * 1024, 1024, p.wt_gu + (size_t)pn * 128 * 1024, 1024, 16, smem, tid);
#pragma unroll
        for (int m = 0; m < 4; ++m) {
            const int row = pm * 128 + wr * 64 + m * 16 + fr;
            const float r = 1.0f / sqrtf(p.rs_h1[row] * (1.0f / 1024.0f) + EPS);
#pragma unroll
            for (int n = 0; n < 2; ++n) {
                f32x4 a;
#pragma unroll
                for (int j = 0; j < 4; ++j) { const float g = acc[m][n][j] * r, u = acc[m][n + 2][j] * r; a[j] = g * u / (1.0f + __expf(-g)); }
                st_bf16x4(p.act + (size_t)row * 2816 + pn * 64 + wc * 32 + n * 16 + 4 * fq, a);
            }
        }
    }
}

__device__ void phase6(const Params& p, unsigned char* smem, int tid) {
    const int wid = tid >> 6, lane = tid & 63, wr = wid >> 1, wc = wid & 1, fr = lane & 15, fq = lane >> 4;
    for (int L = blockIdx.x; L < 512 * 8; L += gridDim.x) {
        int pm, pn; tile_decode(L, 8, pm, pn);
        f32x4 acc[4][4]; zero_acc(acc);
        gemm_kloop(acc, p.act + (size_t)pm * 128 * 2816, 2816, p.wt_d + (size_t)pn * 128 * 2816, 2816, 44, smem, tid);
#pragma unroll
        for (int m = 0; m < 4; ++m) {
            const int row = pm * 128 + wr * 64 + m * 16 + fr;
            float ss = 0.f;
#pragma unroll
            for (int n = 0; n < 4; ++n) {
                const int col = pn * 128 + wc * 64 + n * 16 + 4 * fq;
                float* op = p.out + (size_t)row * 1024 + col;
                const f32x4 hv = *(const f32x4*)op + acc[m][n];
                ss += hv[0] * hv[0] + hv[1] * hv[1] + hv[2] * hv[2] + hv[3] * hv[3];
                *(f32x4*)op = hv;
                st_bf16x4(p.hb + (size_t)row * 1024 + col, hv);
            }
            ss = row_sumsq_reduce(ss);
            if (fq == 0) atomic_addf(p.rs_h2 + row, ss);
        }
    }
}

__device__ void phase_pb(const Params& p, int tid) {
    const int gt = blockIdx.x * 256 + tid, nt = gridDim.x * 256;
    for (int idx = gt; idx < T * 64; idx += nt) {
        const int row = idx >> 6, c = (idx & 63) * 4;
        const float* pr = row < TP ? p.p_p + (size_t)row * 256 : p.p_s + (size_t)(row - TP) * 256;
        st_bf16x4(p.pb + (size_t)row * 256 + c, *(const f32x4*)(pr + c));
    }
}

__device__ void phase8(const Params& p, unsigned char* smem, int tid) {
    const int wid = tid >> 6, lane = tid & 63, wr = wid >> 1, wc = wid & 1, fr = lane & 15, fq = lane >> 4;
    for (int L = blockIdx.x; L < 512 * 8; L += gridDim.x) {
        int pm, pn; tile_decode(L, 8, pm, pn);
        f32x4 acc[4][4], acc2[4][4]; zero_acc(acc); zero_acc(acc2);
        gemm_kloop(acc, p.hb + (size_t)pm * 128 * 1024, 1024, p.wt_pg + (size_t)pn * 128 * 1024, 1024, 16, smem, tid);
        gemm_kloop(acc2, p.pb + (size_t)pm * 128 * 256, 256, p.wt_pp + (size_t)pn * 128 * 256, 256, 4, smem, tid);
#pragma unroll
        for (int m = 0; m < 4; ++m) {
            const int row = pm * 128 + wr * 64 + m * 16 + fr;
            const float r = 1.0f / sqrtf(p.rs_h2[row] * (1.0f / 1024.0f) + EPS);
            float ss = 0.f;
#pragma unroll
            for (int n = 0; n < 4; ++n) {
                const int col = pn * 128 + wc * 64 + n * 16 + 4 * fq;
                float* op = p.out + (size_t)row * 1024 + col;
                f32x4 hv = *(const f32x4*)op;
#pragma unroll
                for (int j = 0; j < 4; ++j) { const float gt = 1.0f / (1.0f + __expf(-acc[m][n][j] * r)); hv[j] += gt * acc2[m][n][j]; }
                ss += hv[0] * hv[0] + hv[1] * hv[1] + hv[2] * hv[2] + hv[3] * hv[3];
                *(f32x4*)op = hv;
            }
            ss = row_sumsq_reduce(ss);
            if (fq == 0) atomic_addf(p.rs_h3 + row, ss);
        }
    }
}

__device__ void phase9(const Params& p, int tid) {
    const int gt = blockIdx.x * 256 + tid, nt = gridDim.x * 256;
    for (int idx = gt; idx < T * 256; idx += nt) {
        const int row = idx >> 8, c = (idx & 255) * 4;
        const float r = 1.0f / sqrtf(p.rs_h3[row] * (1.0f / 1024.0f) + EPS);
        float* op = p.out + (size_t)row * 1024 + c;
        const f32x4 g = *(const f32x4*)(p.g_final + c);
        *(f32x4*)op = *(const f32x4*)op * r * g;
    }
}

__global__ void __launch_bounds__(256, 2) mega(KArgs ka) {
    __shared__ __attribute__((aligned(16))) unsigned char smem[65536];
    const int tid = threadIdx.x;
    const int lo = ka.ph_lo, hi = ka.ph_hi;
#define RUN_PHASE(N, CALL) if (lo <= N && N < hi) { { const Params p = make_params(ka); CALL; } if (N + 1 < hi) cg::this_grid().sync(); }
    RUN_PHASE(0, phase0(p, smem, tid))
    RUN_PHASE(1, phase1(p, smem, tid))
    RUN_PHASE(2, phase2(p, smem, tid))
    RUN_PHASE(3, phase3(p, smem, tid))
    RUN_PHASE(4, phase4(p, smem, tid))
    RUN_PHASE(5, phase5(p, smem, tid))
    RUN_PHASE(6, phase6(p, smem, tid))
    RUN_PHASE(7, phase_pb(p, tid))
    RUN_PHASE(8, phase8(p, smem, tid))
    RUN_PHASE(9, phase9(p, tid))
#undef RUN_PHASE
}

extern "C" void kernel_launch(void* const* d_in, const int* in_sizes, int n_in, void* d_out, int out_size, void* d_ws, size_t ws_size, hipStream_t stream) {
    static int grid = 0;
    if (grid == 0) {
        int dev = 0, cus = 0, per_cu = 0;
        hipGetDevice(&dev);
        hipDeviceGetAttribute(&cus, hipDeviceAttributeMultiprocessorCount, dev);
        hipOccupancyMaxActiveBlocksPerMultiprocessor(&per_cu, (const void*)mega, 256, 0);
        if (per_cu < 1) per_cu = 1;
        if (per_cu > 2) per_cu = 2;
        grid = cus * per_cu;
        if (ws_size < ((size_t)512 << 20)) fprintf(stderr, "kernel_launch: workspace too small (%zu)\n", ws_size);
    }
    KArgs p{};
    for (int i = 0; i < 22; ++i) p.in[i] = (const float*)d_in[i];
    p.out = (float*)d_out; p.ws = (unsigned char*)d_ws;
#if MULTI_LAUNCH
    for (int ph = 0; ph < NPHASE; ++ph) {
        p.ph_lo = ph; p.ph_hi = ph + 1;
        hipLaunchKernelGGL(mega, dim3(grid), dim3(256), 0, stream, p);
    }
#else
    p.ph_lo = 0; p.ph_hi = NPHASE;
    void* args[] = {&p};
    hipError_t e = hipLaunchCooperativeKernel((const void*)mega, dim3(grid), dim3(256), args, 0, stream);
    if (e != hipSuccess) fprintf(stderr, "cooperative launch failed: %s (grid %d)\n", hipGetErrorString(e), grid);
#endif
}
```

```cpp
#include <hip/hip_runtime.h>
#include <hip/hip_cooperative_groups.h>
#include <cstdio>
#include <cstdint>
namespace cg = cooperative_groups;

#ifndef PREFIX_K
#define PREFIX_K 0
#endif
#ifndef MULTI_LAUNCH
#define MULTI_LAUNCH 0
#endif

typedef unsigned short bf16_t;
typedef short bf16x8 __attribute__((ext_vector_type(8)));
typedef float f32x2 __attribute__((ext_vector_type(2)));
typedef float f32x4 __attribute__((ext_vector_type(4)));
typedef float f32x16 __attribute__((ext_vector_type(16)));
typedef unsigned u32x2 __attribute__((ext_vector_type(2)));
typedef unsigned u32x4 __attribute__((ext_vector_type(4)));
typedef __bf16 hbf16x2 __attribute__((ext_vector_type(2)));

#define DI __device__ __forceinline__

constexpr int T = 65536, TP = 32768;
constexpr float EPS = 1e-6f;
constexpr float LOG2E = 1.4426950408889634f;
constexpr float QSCALE_SWA = 0.125f * LOG2E;
constexpr float QSCALE_MLA = 0.10206207261596577f * LOG2E;
constexpr int NPHASE = 10;
constexpr int NTHR = 512;
constexpr int LDS_BYTES = 131072;

struct KArgs { const float* in[22]; float* out; unsigned char* ws; int ph_lo, ph_hi; };

struct Params {
    const float *x_p, *x_s, *p_p, *p_s;
    const float *g_mix, *w_in, *g_cq, *w_uq, *g_ckv, *w_ukv, *sink, *g_swa, *g_mla, *w_o, *g_ffn, *w_gate, *w_up, *w_down, *g_ple, *w_pg, *w_pp, *g_final;
    float* out;
    bf16_t *wt_in, *wt_uq, *wt_ukv, *wt_o, *wt_gu, *wt_d, *wt_pg, *wt_pp;
    float *rx, *rs_cq, *rs_ckv, *rs_oswa, *rs_omla, *rs_h1, *rs_h2, *rs_h3;
    f32x2* rope;
    bf16_t *xb, *cq, *ckv, *qm;
    bf16_t *o, *qs, *ks, *vst, *kr, *km, *vmt, *hb, *act, *pb, *ppb;
};

DI Params make_params(const KArgs& a) {
    Params p;
    const float* const* in = a.in;
    p.x_p = in[0]; p.x_s = in[1]; p.p_p = in[2]; p.p_s = in[3];
    p.g_mix = in[4]; p.w_in = in[5]; p.g_cq = in[6]; p.w_uq = in[7]; p.g_ckv = in[8]; p.w_ukv = in[9]; p.sink = in[10];
    p.g_swa = in[11]; p.g_mla = in[12]; p.w_o = in[13]; p.g_ffn = in[14]; p.w_gate = in[15]; p.w_up = in[16]; p.w_down = in[17];
    p.g_ple = in[18]; p.w_pg = in[19]; p.w_pp = in[20]; p.g_final = in[21];
    p.out = a.out;
    unsigned char* ws = a.ws; unsigned char* ob = (unsigned char*)a.out;
    constexpr size_t MB = (size_t)1 << 20;
    size_t off = 0;
    p.wt_in = (bf16_t*)(ws + off); off += (size_t)1280 * 1024 * 2;
    p.wt_uq = (bf16_t*)(ws + off); off += (size_t)768 * 256 * 2;
    p.wt_ukv = (bf16_t*)(ws + off); off += (size_t)1024 * 128 * 2;
    p.wt_o = (bf16_t*)(ws + off); off += (size_t)1024 * 1024 * 2;
    p.wt_gu = (bf16_t*)(ws + off); off += (size_t)5632 * 1024 * 2;
    p.wt_d = (bf16_t*)(ws + off); off += (size_t)1024 * 2816 * 2;
    p.wt_pg = (bf16_t*)(ws + off); off += (size_t)1024 * 1024 * 2;
    p.wt_pp = (bf16_t*)(ws + off); off += (size_t)1024 * 256 * 2;
    float* misc = (float*)(ws + 25 * MB);
    p.rx = misc; p.rs_cq = misc + T; p.rs_ckv = misc + 2 * T; p.rs_oswa = misc + 3 * T; p.rs_omla = misc + 4 * T; p.rs_h1 = misc + 5 * T; p.rs_h2 = misc + 6 * T; p.rs_h3 = misc + 7 * T;
    p.rope = (f32x2*)(ws + 27 * MB);
    p.o = (bf16_t*)(ws + 32 * MB); p.qs = (bf16_t*)(ws + 160 * MB); p.ks = (bf16_t*)(ws + 224 * MB); p.vst = (bf16_t*)(ws + 240 * MB);
    p.kr = (bf16_t*)(ws + 256 * MB); p.km = (bf16_t*)(ws + 264 * MB); p.vmt = (bf16_t*)(ws + 328 * MB);
    p.hb = (bf16_t*)(ws + 384 * MB); p.act = (bf16_t*)(ws + 32 * MB); p.pb = (bf16_t*)(ws + 32 * MB); p.ppb = (bf16_t*)(ws + 64 * MB);
    p.xb = (bf16_t*)(ob); p.cq = (bf16_t*)(ob + 128 * MB); p.ckv = (bf16_t*)(ob + 160 * MB); p.qm = (bf16_t*)(ob);
    return p;
}

DI unsigned cvt_pk(float lo, float hi) {
    f32x2 v = {lo, hi};
    hbf16x2 b = __builtin_convertvector(v, hbf16x2);
    return __builtin_bit_cast(unsigned, b);
}
DI void st_bf16x4(bf16_t* p, f32x4 v) { u32x2 w; w.x = cvt_pk(v[0], v[1]); w.y = cvt_pk(v[2], v[3]); *(u32x2*)p = w; }
DI bf16_t f2bf(float x) { unsigned u = __float_as_uint(x); u += 0x7fffu + ((u >> 16) & 1u); return (bf16_t)(u >> 16); }
DI void glds16(const void* g, void* l) { __builtin_amdgcn_global_load_lds((const unsigned*)g, (__attribute__((address_space(3))) unsigned*)l, 16, 0, 0); }
DI float fexp2(float x) { return __builtin_amdgcn_exp2f(x); }
DI void atomic_addf(float* p, float v) { unsafeAtomicAdd(p, v); }

constexpr int HT = 128 * 64;
DI int lds_byte(int r, int c) { const int st = (r >> 4) * 2 + (c >> 5), rr = r & 15, cc = c & 31, ob = rr * 64 + cc * 2; return st * 1024 + (ob ^ (((ob >> 9) & 1) << 5)); }
DI void stage_rc(int b, int& R, int& C) { const int st = b / 1024, sb = b % 1024, swz = sb ^ (((sb >> 9) & 1) << 5); R = (st >> 1) * 16 + swz / 64; C = (st & 1) * 32 + (swz % 64) / 2; }

DI void gemm256(f32x4 (&acc)[2][2][4][2], const bf16_t* A, int lda, const bf16_t* Bt, int ldb, int nt, unsigned char* smem, int tid_in) {
    bf16_t* shm = (bf16_t*)smem;
    int tid = tid_in; asm volatile("" : "+v"(tid));
    const int wid = __builtin_amdgcn_readfirstlane(tid >> 6), lane = tid & 63, wr = wid >> 2, wc = wid & 3, fr = lane & 15, fq = lane >> 4;
    int R0, C0, R1, C1; stage_rc(tid * 16, R0, C0); stage_rc(tid * 16 + 8192, R1, C1);
    const unsigned oa0 = (unsigned)(R0 * lda + C0), oa1 = (unsigned)(R1 * lda + C1), ob0 = (unsigned)(R0 * ldb + C0), ob1 = (unsigned)(R1 * ldb + C1);
    const size_t ha = (size_t)128 * lda, hb = (size_t)128 * ldb;
#define SA(b, h) (shm + ((b) * 2 + (h)) * HT)
#define SB(b, h) (shm + (4 + (b) * 2 + (h)) * HT)
#define STAGE_A(P, h, kt) do { const bf16_t* g_ = A + (h) * ha + (size_t)(kt) * 64; glds16(g_ + oa0, (char*)(P) + tid * 16); glds16(g_ + oa1, (char*)(P) + tid * 16 + 8192); } while (0)
#define STAGE_B(P, h, kt) do { const bf16_t* g_ = Bt + (h) * hb + (size_t)(kt) * 64; glds16(g_ + ob0, (char*)(P) + tid * 16); glds16(g_ + ob1, (char*)(P) + tid * 16 + 8192); } while (0)
#define LDA(dst, b, h) for (int m = 0; m < 4; ++m) for (int k = 0; k < 2; ++k) dst[m][k] = *reinterpret_cast<const bf16x8*>((char*)SA(b, h) + lds_byte(wr * 64 + m * 16 + fr, k * 32 + fq * 8))
#define LDB(dst, b, h) for (int n = 0; n < 2; ++n) for (int k = 0; k < 2; ++k) dst[n][k] = *reinterpret_cast<const bf16x8*>((char*)SB(b, h) + lds_byte(wc * 32 + n * 16 + fr, k * 32 + fq * 8))
#define MMA(ai, bj, At_, Bt_) do { __builtin_amdgcn_s_setprio(1); \
    for (int m = 0; m < 4; ++m) for (int n = 0; n < 2; ++n) for (int k = 0; k < 2; ++k) \
        acc[ai][bj][m][n] = __builtin_amdgcn_mfma_f32_16x16x32_bf16(Bt_[n][k], At_[m][k], acc[ai][bj][m][n], 0, 0, 0); \
    __builtin_amdgcn_s_setprio(0); } while (0)
#define WAIT_V(n) asm volatile("s_waitcnt vmcnt(" #n ")" ::: "memory")
#define WAIT_L(n) asm volatile("s_waitcnt lgkmcnt(" #n ")" ::: "memory")
#define BAR __builtin_amdgcn_s_barrier()
#define SCHED __builtin_amdgcn_sched_barrier(0)
    bf16x8 At[4][2], B0[2][2], B1[2][2];
    STAGE_B(SB(0, 0), 0, 0); STAGE_A(SA(0, 0), 0, 0);
    STAGE_B(SB(0, 1), 1, 0); STAGE_A(SA(0, 1), 1, 0);
    if (wr == 1) BAR;
    WAIT_V(4); BAR;
    STAGE_B(SB(1, 0), 0, 1); STAGE_A(SA(1, 0), 0, 1); STAGE_B(SB(1, 1), 1, 1);
    WAIT_V(6); BAR;
#pragma unroll 1
    for (int t = 0; t < nt - 2; t += 2) {
        LDB(B0, 0, 0); SCHED; LDA(At, 0, 0); STAGE_A(SA(1, 1), 1, t + 1);
        WAIT_L(8); BAR; WAIT_L(0); MMA(0, 0, At, B0); BAR; SCHED;
        LDB(B1, 0, 1); STAGE_B(SB(0, 0), 0, t + 2);
        BAR; WAIT_L(0); MMA(0, 1, At, B1); BAR;
        LDA(At, 0, 1); STAGE_A(SA(0, 0), 0, t + 2);
        BAR; WAIT_L(0); MMA(1, 0, At, B0); BAR; SCHED;
        STAGE_B(SB(0, 1), 1, t + 2);
        WAIT_V(6); BAR; MMA(1, 1, At, B1); BAR;
        LDB(B0, 1, 0); SCHED; LDA(At, 1, 0); STAGE_A(SA(0, 1), 1, t + 2);
        WAIT_L(8); BAR; WAIT_L(0); MMA(0, 0, At, B0); BAR; SCHED;
        LDB(B1, 1, 1); STAGE_B(SB(1, 0), 0, t + 3);
        BAR; WAIT_L(0); MMA(0, 1, At, B1); BAR;
        LDA(At, 1, 1); STAGE_A(SA(1, 0), 0, t + 3);
        BAR; WAIT_L(0); MMA(1, 0, At, B0); BAR; SCHED;
        STAGE_B(SB(1, 1), 1, t + 3);
        WAIT_V(6); BAR; MMA(1, 1, At, B1); BAR;
    }
    { LDB(B0, 0, 0); LDA(At, 0, 0); STAGE_A(SA(1, 1), 1, nt - 1);
      BAR; WAIT_L(0); MMA(0, 0, At, B0); BAR;
      LDB(B1, 0, 1); BAR; WAIT_L(0); MMA(0, 1, At, B1); BAR;
      LDA(At, 0, 1); WAIT_V(4); BAR; WAIT_L(0); MMA(1, 0, At, B0); MMA(1, 1, At, B1); BAR; }
    { LDB(B0, 1, 0); LDA(At, 1, 0); WAIT_V(2); BAR; WAIT_L(0); MMA(0, 0, At, B0); BAR;
      LDB(B1, 1, 1); WAIT_V(0); BAR; WAIT_L(0); MMA(0, 1, At, B1); BAR;
      LDA(At, 1, 1); BAR; WAIT_L(0); MMA(1, 0, At, B0); MMA(1, 1, At, B1); BAR; }
    if (wr == 0) BAR;
#undef SA
#undef SB
#undef STAGE_A
#undef STAGE_B
#undef LDA
#undef LDB
#undef MMA
#undef WAIT_V
#undef WAIT_L
#undef BAR
#undef SCHED
}

DI void tile_decode(int L, int nN, int& pm, int& pn) {
    const int q = (256 * nN) >> 3, xcd = L & 7, off = L >> 3;
    const int wgid = xcd * q + off, nig = 8 * nN, gid = wgid / nig, rem = wgid % nig;
    pm = gid * 8 + (rem & 7); pn = rem >> 3;
}

DI void zero_acc(f32x4 (&acc)[2][2][4][2]) {
#pragma unroll
    for (int a = 0; a < 2; ++a)
#pragma unroll
        for (int b = 0; b < 2; ++b)
#pragma unroll
            for (int m = 0; m < 4; ++m)
#pragma unroll
                for (int n = 0; n < 2; ++n) acc[a][b][m][n] = (f32x4){0.f, 0.f, 0.f, 0.f};
}
#define EPI_LANES() int fr = fr0, fq = fq0; asm volatile("" : "+v"(fr), "+v"(fq))
DI float sumsq4(f32x4 v) { return v[0] * v[0] + v[1] * v[1] + v[2] * v[2] + v[3] * v[3]; }

DI float row_sumsq_reduce(float s) { s += __shfl_xor(s, 16); s += __shfl_xor(s, 32); return s; }

DI void prep_tile(const float* src, const float* src_alt, int Nsrc, const float* gain, const float* gain_hi, bf16_t* dst, int K, int mode,
                  int kt, int nt, float* tl, int tid) {
    const int k0 = kt * 64, n0 = nt * 64, tx = tid & 63, ty = tid >> 6;
    const int n = n0 + tx;
    const float* s = src; int sc = n; bool valid = true;
    if (mode == 1) {
        const int tile = n >> 8, within = n & 255;
        sc = tile * 128 + (within & 127); s = (within >> 7) ? src_alt : src;
    } else valid = n < Nsrc;
    for (int i = ty; i < 64; i += 8) {
        const int k = k0 + i;
        float v = valid ? s[(size_t)k * Nsrc + sc] : 0.f;
        float g = 1.f;
        if (gain) g = (gain_hi && k >= 512) ? gain_hi[k - 512] : gain[k];
        tl[i * 65 + tx] = v * g;
    }
    __syncthreads();
    const int r = tid >> 3, kc = (tid & 7) * 8;
    u32x4 w0;
    w0.x = cvt_pk(tl[(kc + 0) * 65 + r], tl[(kc + 1) * 65 + r]); w0.y = cvt_pk(tl[(kc + 2) * 65 + r], tl[(kc + 3) * 65 + r]);
    w0.z = cvt_pk(tl[(kc + 4) * 65 + r], tl[(kc + 5) * 65 + r]); w0.w = cvt_pk(tl[(kc + 6) * 65 + r], tl[(kc + 7) * 65 + r]);
    *(u32x4*)(dst + (size_t)(n0 + r) * K + k0 + kc) = w0;
    __syncthreads();
}

__device__ void phase0(const Params& p, unsigned char* smem, int tid) {
    float* tl = (float*)smem;
    constexpr int C0 = 320, C1 = C0 + 48, C2 = C1 + 32, C3 = C2 + 256, C4 = C3 + 1408, C5 = C4 + 704, C6 = C5 + 256, C7 = C6 + 64;
    for (int i = blockIdx.x; i < C7; i += gridDim.x) {
        if (i < C0)      { const int j = i;      prep_tile(p.w_in, nullptr, 1184, p.g_mix, nullptr, p.wt_in, 1024, 0, j % 16, j / 16, tl, tid); }
        else if (i < C1) { const int j = i - C0; prep_tile(p.w_uq, nullptr, 768, p.g_cq, nullptr, p.wt_uq, 256, 0, j % 4, j / 4, tl, tid); }
        else if (i < C2) { const int j = i - C1; prep_tile(p.w_ukv, nullptr, 1024, p.g_ckv, nullptr, p.wt_ukv, 128, 0, j % 2, j / 2, tl, tid); }
        else if (i < C3) { const int j = i - C2; prep_tile(p.w_o, nullptr, 1024, p.g_swa, p.g_mla, p.wt_o, 1024, 0, j % 16, j / 16, tl, tid); }
        else if (i < C4) { const int j = i - C3; prep_tile(p.w_gate, p.w_up, 2816, p.g_ffn, nullptr, p.wt_gu, 1024, 1, j % 16, j / 16, tl, tid); }
        else if (i < C5) { const int j = i - C4; prep_tile(p.w_down, nullptr, 1024, nullptr, nullptr, p.wt_d, 2816, 0, j % 44, j / 44, tl, tid); }
        else if (i < C6) { const int j = i - C5; prep_tile(p.w_pg, nullptr, 1024, p.g_ple, nullptr, p.wt_pg, 1024, 0, j % 16, j / 16, tl, tid); }
        else             { const int j = i - C6; prep_tile(p.w_pp, nullptr, 1024, nullptr, nullptr, p.wt_pp, 256, 0, j % 4, j / 4, tl, tid); }
    }
    const int lane = tid & 63, gw = blockIdx.x * (NTHR / 64) + (tid >> 6), nw = gridDim.x * (NTHR / 64);
    for (int row = gw; row < T; row += nw) {
        const float* xr = row < TP ? p.x_p + (size_t)row * 1024 : p.x_s + (size_t)(row - TP) * 1024;
        f32x4 v[4]; float ss = 0.f;
#pragma unroll
        for (int i = 0; i < 4; ++i) { v[i] = *(const f32x4*)(xr + (i * 64 + lane) * 4); ss += sumsq4(v[i]); }
#pragma unroll
        for (int o = 32; o >= 1; o >>= 1) ss += __shfl_xor(ss, o);
        if (lane == 0) p.rx[row] = 1.0f / sqrtf(ss * (1.0f / 1024.0f) + EPS);
#pragma unroll
        for (int i = 0; i < 4; ++i) st_bf16x4(p.xb + (size_t)row * 1024 + (i * 64 + lane) * 4, v[i]);
    }
    const int gt = blockIdx.x * NTHR + tid, nt = gridDim.x * NTHR;
    for (int idx = gt; idx < 16384 * 16; idx += nt) {
        const int s = idx >> 4, i = idx & 15;
        const float inv = (float)pow(10000.0, -(double)i / 16.0);
        const float ang = (float)s * inv;
        const double a = (double)ang;
        p.rope[idx] = (f32x2){(float)cos(a), (float)sin(a)};
    }
    for (int idx = gt; idx < 7 * T; idx += nt) p.rs_cq[idx] = 0.f;
}

DI void seq_of_row(int row, int& S, int& s) { if (row < TP) { S = 16384; s = row & 16383; } else { S = 4096; s = row & 4095; } }

__device__ void phase1(const Params& p, unsigned char* smem, int tid) {
    const int wid = __builtin_amdgcn_readfirstlane(tid >> 6), lane = tid & 63, wr = wid >> 2, wc = wid & 3, fr0 = lane & 15, fq0 = lane >> 4;
    for (int L = blockIdx.x; L < 256 * 5; L += gridDim.x) {
        int pm, pn; tile_decode(L, 5, pm, pn);
        f32x4 acc[2][2][4][2]; zero_acc(acc);
        gemm256(acc, p.xb + (size_t)pm * 256 * 1024, 1024, p.wt_in + (size_t)pn * 256 * 1024, 1024, 16, smem, tid);
        { EPI_LANES();

#pragma unroll
        for (int ai = 0; ai < 2; ++ai)
#pragma unroll
            for (int m = 0; m < 4; ++m) {
                asm volatile("" ::: "memory");
                const int row = pm * 256 + ai * 128 + wr * 64 + m * 16 + fr;
                const float r = p.rx[row];
                int S, s; seq_of_row(row, S, s);
                const int ct = wc * 32 + 4 * fq;
                if (pn < 2) {
#pragma unroll
                    for (int bj = 0; bj < 2; ++bj)
#pragma unroll
                        for (int n = 0; n < 2; ++n) st_bf16x4(p.qs + (size_t)row * 512 + pn * 256 + bj * 128 + ct + n * 16, acc[ai][bj][m][n] * (r * QSCALE_SWA));
                } else if (pn == 2) {
#pragma unroll
                    for (int n = 0; n < 2; ++n) st_bf16x4(p.ks + (size_t)row * 128 + ct + n * 16, acc[ai][0][m][n] * r);
                    bf16_t* vb = p.vst + (size_t)(row - s) * 128 + s;
#pragma unroll
                    for (int n = 0; n < 2; ++n)
#pragma unroll
                        for (int j = 0; j < 4; ++j) vb[(size_t)(ct + n * 16 + j) * S] = f2bf(acc[ai][1][m][n][j] * r);
                } else if (pn == 3) {
                    float ss = 0.f;
#pragma unroll
                    for (int bj = 0; bj < 2; ++bj)
#pragma unroll
                        for (int n = 0; n < 2; ++n) { const f32x4 v = acc[ai][bj][m][n] * r; ss += sumsq4(v); st_bf16x4(p.cq + (size_t)row * 256 + bj * 128 + ct + n * 16, v); }
                    ss = row_sumsq_reduce(ss);
                    if (fq == 0) atomic_addf(p.rs_cq + row, ss);
                } else {
                    float ss = 0.f;
#pragma unroll
                    for (int n = 0; n < 2; ++n) { const f32x4 v = acc[ai][0][m][n] * r; ss += sumsq4(v); st_bf16x4(p.ckv + (size_t)row * 128 + ct + n * 16, v); }
                    ss = row_sumsq_reduce(ss);
                    if (fq == 0) atomic_addf(p.rs_ckv + row, ss);
                    if (wc == 0) {
                        const f32x4 x1 = acc[ai][1][m][0] * r, x2 = acc[ai][1][m][1] * r; f32x4 o1, o2;
#pragma unroll
                        for (int j = 0; j < 4; ++j) { const f32x2 cs = p.rope[s * 16 + 4 * fq + j]; o1[j] = x1[j] * cs.x - x2[j] * cs.y; o2[j] = x2[j] * cs.x + x1[j] * cs.y; }
                        st_bf16x4(p.kr + (size_t)row * 32 + 4 * fq, o1);
                        st_bf16x4(p.kr + (size_t)row * 32 + 16 + 4 * fq, o2);
                    }
                }
            } }
    }
}

__device__ void phase2(const Params& p, unsigned char* smem, int tid) {
    const int wid = __builtin_amdgcn_readfirstlane(tid >> 6), lane = tid & 63, wr = wid >> 2, wc = wid & 3, fr0 = lane & 15, fq0 = lane >> 4;
    for (int L = blockIdx.x; L < 256 * 7; L += gridDim.x) {
        if (L < 256 * 3) {
            int pm, pn; tile_decode(L, 3, pm, pn);
            f32x4 acc[2][2][4][2]; zero_acc(acc);
            gemm256(acc, p.cq + (size_t)pm * 256 * 256, 256, p.wt_uq + (size_t)pn * 256 * 256, 256, 4, smem, tid);
            { EPI_LANES();

#pragma unroll
            for (int ai = 0; ai < 2; ++ai)
#pragma unroll
                for (int m = 0; m < 4; ++m) {
                    asm volatile("" ::: "memory");
                    const int row = pm * 256 + ai * 128 + wr * 64 + m * 16 + fr;
                    const float r = QSCALE_MLA / sqrtf(p.rs_cq[row] * (1.0f / 256.0f) + EPS);
                    int S, s; seq_of_row(row, S, s);
#pragma unroll
                    for (int bj = 0; bj < 2; ++bj) {
                        const int c0 = pn * 256 + bj * 128 + wc * 32;
                        f32x4 x1 = acc[ai][bj][m][0] * r, x2 = acc[ai][bj][m][1] * r;
                        if (((c0 >> 5) % 3) == 2) {
                            f32x4 o1, o2;
#pragma unroll
                            for (int j = 0; j < 4; ++j) { const f32x2 cs = p.rope[s * 16 + 4 * fq + j]; o1[j] = x1[j] * cs.x - x2[j] * cs.y; o2[j] = x2[j] * cs.x + x1[j] * cs.y; }
                            x1 = o1; x2 = o2;
                        }
                        st_bf16x4(p.qm + (size_t)row * 768 + c0 + 4 * fq, x1);
                        st_bf16x4(p.qm + (size_t)row * 768 + c0 + 16 + 4 * fq, x2);
                    }
                } }
        } else {
            int pm, pn; tile_decode(L - 256 * 3, 4, pm, pn);
            f32x4 acc[2][2][4][2]; zero_acc(acc);
            gemm256(acc, p.ckv + (size_t)pm * 256 * 128, 128, p.wt_ukv + (size_t)pn * 256 * 128, 128, 2, smem, tid);
            { EPI_LANES();

#pragma unroll
            for (int ai = 0; ai < 2; ++ai)
#pragma unroll
                for (int m = 0; m < 4; ++m) {
                    asm volatile("" ::: "memory");
                    const int row = pm * 256 + ai * 128 + wr * 64 + m * 16 + fr;
                    const float r = 1.0f / sqrtf(p.rs_ckv[row] * (1.0f / 128.0f) + EPS);
                    int S, s; seq_of_row(row, S, s);
#pragma unroll
                    for (int bj = 0; bj < 2; ++bj) {
                        const int head = pn * 2 + bj;
                        if (wc < 2) {
#pragma unroll
                            for (int n = 0; n < 2; ++n) st_bf16x4(p.km + (size_t)row * 512 + head * 64 + wc * 32 + n * 16 + 4 * fq, acc[ai][bj][m][n] * r);
                        } else {
                            bf16_t* vb = p.vmt + (size_t)(row - s) * 512 + (size_t)head * 64 * S + s;
#pragma unroll
                            for (int n = 0; n < 2; ++n)
#pragma unroll
                                for (int j = 0; j < 4; ++j) vb[(size_t)((wc - 2) * 32 + n * 16 + 4 * fq + j) * S] = f2bf(acc[ai][bj][m][n][j] * r);
                        }
                    }
                } }
        }
    }
}

DI bf16x8 pack8(const f32x16& x, int s8) {
    u32x4 w;
    w.x = cvt_pk(x[s8 + 0], x[s8 + 1]); w.y = cvt_pk(x[s8 + 2], x[s8 + 3]); w.z = cvt_pk(x[s8 + 4], x[s8 + 5]); w.w = cvt_pk(x[s8 + 6], x[s8 + 7]);
    return __builtin_bit_cast(bf16x8, w);
}

template <bool SWA>
DI void attn_item(const Params& p, unsigned char* smem, int tid, int tok0, int S, int head, int qb) {
    constexpr int NQ = SWA ? 4 : 6;
    constexpr int STG = 20480;
    const int w = tid >> 6, lane = tid & 63, r = lane & 31, h = lane >> 5;
    const int krow = (r & 3) | ((r & 4) << 1) | ((r & 8) >> 1) | (r & 16);
    const int kswz = (krow >> 1) & 7, krswz = (krow >> 2) & 3, vswz = (r >> 1) & 7;
    const int qpos = qb * 256 + w * 32 + r;
    const int q_tok = tok0 + qpos;
    bf16x8 qf[NQ];
    {
        const bf16_t* qptr = SWA ? p.qs + (size_t)q_tok * 512 + head * 64 : p.qm + (size_t)q_tok * 768 + head * 96;
#pragma unroll
        for (int ks = 0; ks < NQ; ++ks) qf[ks] = *(const bf16x8*)(qptr + ks * 16 + h * 8);
    }
    const int ldk = SWA ? 128 : 512;
    const bf16_t* kn_base = SWA ? p.ks + (size_t)tok0 * 128 + (head >> 2) * 64 : p.km + (size_t)tok0 * 512 + head * 64;
    const bf16_t* kr_base = p.kr + (size_t)tok0 * 32;
    const bf16_t* vt_base = SWA ? p.vst + (size_t)tok0 * 128 + (size_t)(head >> 2) * 64 * S : p.vmt + (size_t)tok0 * 512 + (size_t)head * 64 * S;
    int kt0 = 0, kt1 = S >> 6;
    if (SWA) { int lo = qb * 256 - 128, hi = qb * 256 + 384; lo = lo < 0 ? 0 : lo; hi = hi > S ? S : hi; kt0 = lo >> 6; kt1 = hi >> 6; }
    float slope2 = 0.f, mrun = -1e30f, lrun = 0.f;
    if (SWA) { slope2 = exp2f(-(float)(head + 1)) * LOG2E; mrun = p.sink[head] * LOG2E; lrun = h == 0 ? 1.f : 0.f; }

    f32x16 o0, o1;
#pragma unroll
    for (int i = 0; i < 16; ++i) { o0[i] = 0.f; o1[i] = 0.f; }

    auto stage = [&](int kt, int buf) {
        unsigned char* sb = smem + buf * STG;
        const int key0 = kt * 64;
        const int row = tid >> 3, ch = (tid & 7) ^ ((tid >> 4) & 7);
        glds16(kn_base + (size_t)(key0 + row) * ldk + ch * 8, sb + tid * 16);
        glds16(vt_base + (size_t)row * S + key0 + ch * 8, sb + 8192 + tid * 16);
        if (!SWA && tid < 256) {
            const int row4 = tid >> 2, c4 = (tid & 3) ^ ((row4 >> 2) & 3);
            glds16(kr_base + (size_t)(key0 + row4) * 32 + c4 * 8, sb + 16384 + tid * 16);
        }
    };

    stage(kt0, 0);
    for (int kt = kt0; kt < kt1; ++kt) {
        const int buf = (kt - kt0) & 1;
        asm volatile("s_waitcnt vmcnt(0)" ::: "memory");
        __syncthreads();
        if (kt + 1 < kt1) stage(kt + 1, buf ^ 1);
        const int key0 = kt * 64;
        bool active = true;
        if (SWA) { const int q0w = qb * 256 + w * 32; active = !(key0 > q0w + 31 + 128 || key0 + 63 < q0w - 128); }
        if (active) {
            const unsigned char* sb = smem + buf * STG;
            f32x16 s0, s1;
#pragma unroll
            for (int i = 0; i < 16; ++i) { s0[i] = 0.f; s1[i] = 0.f; }
#pragma unroll
            for (int ks = 0; ks < 4; ++ks) {
                const int co = ((2 * ks + h) ^ kswz) * 16;
                const bf16x8 a0 = *(const bf16x8*)(sb + krow * 128 + co);
                const bf16x8 a1 = *(const bf16x8*)(sb + (32 + krow) * 128 + co);
                s0 = __builtin_amdgcn_mfma_f32_32x32x16_bf16(a0, qf[ks], s0, 0, 0, 0);
                s1 = __builtin_amdgcn_mfma_f32_32x32x16_bf16(a1, qf[ks], s1, 0, 0, 0);
            }
            if (!SWA) {
#pragma unroll
                for (int ks = 0; ks < 2; ++ks) {
                    const int co = ((2 * ks + h) ^ krswz) * 16;
                    const bf16x8 a0 = *(const bf16x8*)(sb + 16384 + krow * 64 + co);
                    const bf16x8 a1 = *(const bf16x8*)(sb + 16384 + (32 + krow) * 64 + co);
                    s0 = __builtin_amdgcn_mfma_f32_32x32x16_bf16(a0, qf[NQ - 2 + ks], s0, 0, 0, 0);
                    s1 = __builtin_amdgcn_mfma_f32_32x32x16_bf16(a1, qf[NQ - 2 + ks], s1, 0, 0, 0);
                }
            }
            if (SWA) {
#pragma unroll
                for (int i = 0; i < 16; ++i) {
                    const int kidx = (i & 3) + 4 * ((i >> 2) & 1) + 8 * h + 16 * ((i >> 3) & 1);
                    const int d0 = key0 + kidx - qpos, d1 = d0 + 32;
                    const int a0 = d0 < 0 ? -d0 : d0, a1 = d1 < 0 ? -d1 : d1;
                    s0[i] = a0 <= 128 ? s0[i] - slope2 * (float)a0 : -1e30f;
                    s1[i] = a1 <= 128 ? s1[i] - slope2 * (float)a1 : -1e30f;
                }
            }
            float mx = fmaxf(s0[0], s1[0]);
#pragma unroll
            for (int i = 1; i < 16; ++i) mx = fmaxf(fmaxf(mx, s0[i]), s1[i]);
            mx = fmaxf(mx, __shfl_xor(mx, 32));
            if (__any(mx > mrun + 6.0f)) {
                const float mnew = fmaxf(mrun, mx);
                const float alpha = fexp2(mrun - mnew);
                mrun = mnew; lrun *= alpha;
#pragma unroll
                for (int i = 0; i < 16; ++i) { o0[i] *= alpha; o1[i] *= alpha; }
            }
            float ps = 0.f;
#pragma unroll
            for (int i = 0; i < 16; ++i) { s0[i] = fexp2(s0[i] - mrun); s1[i] = fexp2(s1[i] - mrun); ps += s0[i] + s1[i]; }
            lrun += ps;
            const unsigned char* sv = sb + 8192 + r * 128;
#pragma unroll
            for (int blk = 0; blk < 2; ++blk)
#pragma unroll
                for (int s = 0; s < 2; ++s) {
                    const bf16x8 pf = pack8(blk ? s1 : s0, 8 * s);
                    const int co = ((4 * blk + 2 * s + h) ^ vswz) * 16;
                    const bf16x8 v0 = *(const bf16x8*)(sv + co);
                    const bf16x8 v1 = *(const bf16x8*)(sv + 32 * 128 + co);
                    o0 = __builtin_amdgcn_mfma_f32_32x32x16_bf16(v0, pf, o0, 0, 0, 0);
                    o1 = __builtin_amdgcn_mfma_f32_32x32x16_bf16(v1, pf, o1, 0, 0, 0);
                }
        }
    }
    const float l = lrun + __shfl_xor(lrun, 32);
    const float inv = 1.0f / l;
    bf16_t* orow = p.o + (size_t)q_tok * 1024 + (SWA ? 0 : 512) + head * 64;
    float ss = 0.f;
#pragma unroll
    for (int g = 0; g < 4; ++g) {
        const f32x4 v0 = {o0[4 * g] * inv, o0[4 * g + 1] * inv, o0[4 * g + 2] * inv, o0[4 * g + 3] * inv};
        const f32x4 v1 = {o1[4 * g] * inv, o1[4 * g + 1] * inv, o1[4 * g + 2] * inv, o1[4 * g + 3] * inv};
        ss += sumsq4(v0) + sumsq4(v1);
        st_bf16x4(orow + 8 * g + 4 * h, v0);
        st_bf16x4(orow + 32 + 8 * g + 4 * h, v1);
    }
    ss += __shfl_xor(ss, 32);
    if (h == 0) atomic_addf((SWA ? p.rs_oswa : p.rs_omla) + q_tok, ss);
    __syncthreads();
}

__device__ void phase3(const Params& p, unsigned char* smem, int tid) {
    for (int I = blockIdx.x; I < 4096; I += gridDim.x) {
        if (I < 1024) {
            const int rnd = I >> 8, B = I & 255, xcd = B & 7, slot = B >> 3;
            const int combo = xcd + 8 * (rnd >> 1), qb = (rnd & 1) * 32 + slot;
            attn_item<false>(p, smem, tid, (combo >> 3) * 16384, 16384, combo & 7, qb);
        } else if (I < 2048) {
            const int J = I - 1024, rnd = J >> 8, B = J & 255, xcd = B & 7, slot = B >> 3;
            const int combo = xcd * 8 + rnd * 2 + (slot >> 4), qb = slot & 15;
            attn_item<false>(p, smem, tid, TP + (combo >> 3) * 4096, 4096, combo & 7, qb);
        } else {
            const int J = I - 2048, head = J >> 8, tb = (J & 255) * 256;
            int tok0, S;
            if (tb < TP) { tok0 = (tb >> 14) << 14; S = 16384; } else { tok0 = TP + (((tb - TP) >> 12) << 12); S = 4096; }
            attn_item<true>(p, smem, tid, tok0, S, head, (tb - tok0) >> 8);
        }
    }
}

__device__ void phase4(const Params& p, unsigned char* smem, int tid) {
    const int wid = __builtin_amdgcn_readfirstlane(tid >> 6), lane = tid & 63, wr = wid >> 2, wc = wid & 3, fr0 = lane & 15, fq0 = lane >> 4;
    for (int L = blockIdx.x; L < 256 * 4; L += gridDim.x) {
        int pm, pn; tile_decode(L, 4, pm, pn);
        f32x4 acc[2][2][4][2]; zero_acc(acc);
        const bf16_t* A = p.o + (size_t)pm * 256 * 1024; const bf16_t* B = p.wt_o + (size_t)pn * 256 * 1024;
        gemm256(acc, A, 1024, B, 1024, 8, smem, tid);
        { EPI_LANES();

#pragma unroll
        for (int ai = 0; ai < 2; ++ai)
#pragma unroll
            for (int m = 0; m < 4; ++m) {
                asm volatile("" ::: "memory");
                const int row = pm * 256 + ai * 128 + wr * 64 + m * 16 + fr;
                const float f = sqrtf((p.rs_omla[row] * (1.0f / 512.0f) + EPS) / (p.rs_oswa[row] * (1.0f / 512.0f) + EPS));
#pragma unroll
                for (int bj = 0; bj < 2; ++bj)
#pragma unroll
                    for (int n = 0; n < 2; ++n) acc[ai][bj][m][n] *= f;
            } }
        gemm256(acc, A + 512, 1024, B + 512, 1024, 8, smem, tid);
        { EPI_LANES();

#pragma unroll
        for (int ai = 0; ai < 2; ++ai)
#pragma unroll
            for (int m = 0; m < 4; ++m) {
                asm volatile("" ::: "memory");
                const int row = pm * 256 + ai * 128 + wr * 64 + m * 16 + fr;
                const float rm = 1.0f / sqrtf(p.rs_omla[row] * (1.0f / 512.0f) + EPS);
                const float* xr = row < TP ? p.x_p + (size_t)row * 1024 : p.x_s + (size_t)(row - TP) * 1024;
                float ss = 0.f;
#pragma unroll
                for (int bj = 0; bj < 2; ++bj)
#pragma unroll
                    for (int n = 0; n < 2; ++n) {
                        const int col = pn * 256 + bj * 128 + wc * 32 + n * 16 + 4 * fq;
                        const f32x4 hv = *(const f32x4*)(xr + col) + acc[ai][bj][m][n] * rm;
                        ss += sumsq4(hv);
                        *(f32x4*)(p.out + (size_t)row * 1024 + col) = hv;
                        st_bf16x4(p.hb + (size_t)row * 1024 + col, hv);
                    }
                ss = row_sumsq_reduce(ss);
                if (fq == 0) atomic_addf(p.rs_h1 + row, ss);
            } }
    }
}

__device__ void phase5(const Params& p, unsigned char* smem, int tid) {
    const int wid = __builtin_amdgcn_readfirstlane(tid >> 6), lane = tid & 63, wr = wid >> 2, wc = wid & 3, fr0 = lane & 15, fq0 = lane >> 4;
    for (int L = blockIdx.x; L < 256 * 22; L += gridDim.x) {
        int pm, pn; tile_decode(L, 22, pm, pn);
        f32x4 acc[2][2][4][2]; zero_acc(acc);
        gemm256(acc, p.hb + (size_t)pm * 256 * 1024, 1024, p.wt_gu + (size_t)pn * 256 * 1024, 1024, 16, smem, tid);
        { EPI_LANES();

#pragma unroll
        for (int ai = 0; ai < 2; ++ai)
#pragma unroll
            for (int m = 0; m < 4; ++m) {
                asm volatile("" ::: "memory");
                const int row = pm * 256 + ai * 128 + wr * 64 + m * 16 + fr;
                const float r = 1.0f / sqrtf(p.rs_h1[row] * (1.0f / 1024.0f) + EPS);
#pragma unroll
                for (int n = 0; n < 2; ++n) {
                    f32x4 a;
#pragma unroll
                    for (int j = 0; j < 4; ++j) { const float g = acc[ai][0][m][n][j] * r, u = acc[ai][1][m][n][j] * r; a[j] = g * u / (1.0f + __expf(-g)); }
                    st_bf16x4(p.act + (size_t)row * 2816 + pn * 128 + wc * 32 + n * 16 + 4 * fq, a);
                }
            } }
    }
}

__device__ void phase6(const Params& p, unsigned char* smem, int tid) {
    const int wid = __builtin_amdgcn_readfirstlane(tid >> 6), lane = tid & 63, wr = wid >> 2, wc = wid & 3, fr0 = lane & 15, fq0 = lane >> 4;
    for (int L = blockIdx.x; L < 256 * 4; L += gridDim.x) {
        int pm, pn; tile_decode(L, 4, pm, pn);
        f32x4 acc[2][2][4][2]; zero_acc(acc);
        gemm256(acc, p.act + (size_t)pm * 256 * 2816, 2816, p.wt_d + (size_t)pn * 256 * 2816, 2816, 44, smem, tid);
        { EPI_LANES();

#pragma unroll
        for (int ai = 0; ai < 2; ++ai)
#pragma unroll
            for (int m = 0; m < 4; ++m) {
                asm volatile("" ::: "memory");
                const int row = pm * 256 + ai * 128 + wr * 64 + m * 16 + fr;
                float ss = 0.f;
#pragma unroll
                for (int bj = 0; bj < 2; ++bj)
#pragma unroll
                    for (int n = 0; n < 2; ++n) {
                        const int col = pn * 256 + bj * 128 + wc * 32 + n * 16 + 4 * fq;
                        float* op = p.out + (size_t)row * 1024 + col;
                        const f32x4 hv = *(const f32x4*)op + acc[ai][bj][m][n];
                        ss += sumsq4(hv);
                        *(f32x4*)op = hv;
                        st_bf16x4(p.hb + (size_t)row * 1024 + col, hv);
                    }
                ss = row_sumsq_reduce(ss);
                if (fq == 0) atomic_addf(p.rs_h2 + row, ss);
            } }
    }
}

__device__ void phase_pb(const Params& p, int tid) {
    const int gt = blockIdx.x * NTHR + tid, nt = gridDim.x * NTHR;
    for (int idx = gt; idx < T * 64; idx += nt) {
        const int row = idx >> 6, c = (idx & 63) * 4;
        const float* pr = row < TP ? p.p_p + (size_t)row * 256 : p.p_s + (size_t)(row - TP) * 256;
        st_bf16x4(p.pb + (size_t)row * 256 + c, *(const f32x4*)(pr + c));
    }
}

__device__ void phase8(const Params& p, unsigned char* smem, int tid) {
    const int wid = __builtin_amdgcn_readfirstlane(tid >> 6), lane = tid & 63, wr = wid >> 2, wc = wid & 3, fr0 = lane & 15, fq0 = lane >> 4;
    for (int L = blockIdx.x; L < 256 * 4; L += gridDim.x) {
        int pm, pn; tile_decode(L, 4, pm, pn);
        f32x4 acc[2][2][4][2]; zero_acc(acc);
        gemm256(acc, p.pb + (size_t)pm * 256 * 256, 256, p.wt_pp + (size_t)pn * 256 * 256, 256, 4, smem, tid);
        { EPI_LANES();

#pragma unroll
        for (int ai = 0; ai < 2; ++ai)
#pragma unroll
            for (int m = 0; m < 4; ++m) {
                asm volatile("" ::: "memory");
                const int row = pm * 256 + ai * 128 + wr * 64 + m * 16 + fr;
#pragma unroll
                for (int bj = 0; bj < 2; ++bj)
#pragma unroll
                    for (int n = 0; n < 2; ++n) st_bf16x4(p.ppb + (size_t)row * 1024 + pn * 256 + bj * 128 + wc * 32 + n * 16 + 4 * fq, acc[ai][bj][m][n]);
            } }
        zero_acc(acc);
        gemm256(acc, p.hb + (size_t)pm * 256 * 1024, 1024, p.wt_pg + (size_t)pn * 256 * 1024, 1024, 16, smem, tid);
        { EPI_LANES();

#pragma unroll
        for (int ai = 0; ai < 2; ++ai)
#pragma unroll
            for (int m = 0; m < 4; ++m) {
                asm volatile("" ::: "memory");
                const int row = pm * 256 + ai * 128 + wr * 64 + m * 16 + fr;
                const float r = 1.0f / sqrtf(p.rs_h2[row] * (1.0f / 1024.0f) + EPS);
                float ss = 0.f;
#pragma unroll
                for (int bj = 0; bj < 2; ++bj)
#pragma unroll
                    for (int n = 0; n < 2; ++n) {
                        const int col = pn * 256 + bj * 128 + wc * 32 + n * 16 + 4 * fq;
                        float* op = p.out + (size_t)row * 1024 + col;
                        f32x4 hv = *(const f32x4*)op;
                        const u32x2 pw = *(const u32x2*)(p.ppb + (size_t)row * 1024 + col);
                        const float pp[4] = {__uint_as_float(pw.x << 16), __uint_as_float(pw.x & 0xffff0000u), __uint_as_float(pw.y << 16), __uint_as_float(pw.y & 0xffff0000u)};
#pragma unroll
                        for (int j = 0; j < 4; ++j) { const float gt = 1.0f / (1.0f + __expf(-acc[ai][bj][m][n][j] * r)); hv[j] += gt * pp[j]; }
                        ss += sumsq4(hv);
                        *(f32x4*)op = hv;
                    }
                ss = row_sumsq_reduce(ss);
                if (fq == 0) atomic_addf(p.rs_h3 + row, ss);
            } }
    }
}

__device__ void phase9(const Params& p, int tid) {
    const int gt = blockIdx.x * NTHR + tid, nt = gridDim.x * NTHR;
    for (int idx = gt; idx < T * 256; idx += nt) {
        const int row = idx >> 8, c = (idx & 255) * 4;
        const float r = 1.0f / sqrtf(p.rs_h3[row] * (1.0f / 1024.0f) + EPS);
        float* op = p.out + (size_t)row * 1024 + c;
        const f32x4 g = *(const f32x4*)(p.g_final + c);
        *(f32x4*)op = *(const f32x4*)op * r * g;
    }
}

__global__ void __launch_bounds__(512, 2) mega(KArgs ka) {
    extern __shared__ __attribute__((aligned(16))) unsigned char smem[];
    const int tid = threadIdx.x;
    const int lo = ka.ph_lo, hi = ka.ph_hi;
#define RUN_PHASE(N, CALL) if (lo <= N && N < hi) { { const Params p = make_params(ka); CALL; } if (N + 1 < hi) cg::this_grid().sync(); }
#define RUN_PRE(N, CALL) if (N < PREFIX_K) { { const Params p = make_params(ka); CALL; } cg::this_grid().sync(); }
#if PREFIX_K > 0
    RUN_PRE(0, phase0(p, smem, tid))
    RUN_PRE(1, phase1(p, smem, tid))
    RUN_PRE(2, phase2(p, smem, tid))
    RUN_PRE(3, phase3(p, smem, tid))
    RUN_PRE(4, phase4(p, smem, tid))
    RUN_PRE(5, phase5(p, smem, tid))
    RUN_PRE(6, phase6(p, smem, tid))
#endif
    RUN_PHASE(0, phase0(p, smem, tid))
    RUN_PHASE(1, phase1(p, smem, tid))
    RUN_PHASE(2, phase2(p, smem, tid))
    RUN_PHASE(3, phase3(p, smem, tid))
    RUN_PHASE(4, phase4(p, smem, tid))
    RUN_PHASE(5, phase5(p, smem, tid))
    RUN_PHASE(6, phase6(p, smem, tid))
    RUN_PHASE(7, phase_pb(p, tid))
    RUN_PHASE(8, phase8(p, smem, tid))
    RUN_PHASE(9, phase9(p, tid))
#undef RUN_PRE
#undef RUN_PHASE
}

extern "C" void kernel_launch(void* const* d_in, const int* in_sizes, int n_in, void* d_out, int out_size, void* d_ws, size_t ws_size, hipStream_t stream) {
    static int grid = 0;
    if (grid == 0) {
        int dev = 0, cus = 0, per_cu = 0;
        (void)hipGetDevice(&dev);
        (void)hipDeviceGetAttribute(&cus, hipDeviceAttributeMultiprocessorCount, dev);
        (void)hipFuncSetAttribute((const void*)mega, hipFuncAttributeMaxDynamicSharedMemorySize, LDS_BYTES);
        (void)hipOccupancyMaxActiveBlocksPerMultiprocessor(&per_cu, (const void*)mega, NTHR, LDS_BYTES);
        if (per_cu < 1) fprintf(stderr, "kernel_launch: occupancy query reports %d blocks per CU\n", per_cu);
        grid = cus;
        if (ws_size < ((size_t)512 << 20)) fprintf(stderr, "kernel_launch: workspace too small (%zu)\n", ws_size);
    }
    KArgs p{};
    for (int i = 0; i < 22; ++i) p.in[i] = (const float*)d_in[i];
    p.out = (float*)d_out; p.ws = (unsigned char*)d_ws;
#if MULTI_LAUNCH
    for (int ph = 0; ph < NPHASE; ++ph) {
        p.ph_lo = ph; p.ph_hi = ph + 1;
        hipLaunchKernelGGL(mega, dim3(grid), dim3(NTHR), LDS_BYTES, stream, p);
    }
#else
    p.ph_lo = 0; p.ph_hi = NPHASE;
    void* args[] = {&p};
    hipError_t e = hipLaunchCooperativeKernel((const void*)mega, dim3(grid), dim3(NTHR), args, LDS_BYTES, stream);
    if (e != hipSuccess) fprintf(stderr, "cooperative launch failed: %s (grid %d)\n", hipGetErrorString(e), grid);
#endif
}
```

```cpp
#include <hip/hip_runtime.h>
#include <hip/hip_cooperative_groups.h>
#include <cstdio>
#include <cstdint>
namespace cg = cooperative_groups;

#ifndef PREFIX_K
#define PREFIX_K 0
#endif
#ifndef MULTI_LAUNCH
#define MULTI_LAUNCH 0
#endif

typedef unsigned short bf16_t;
typedef short bf16x8 __attribute__((ext_vector_type(8)));
typedef float f32x2 __attribute__((ext_vector_type(2)));
typedef float f32x4 __attribute__((ext_vector_type(4)));
typedef float f32x16 __attribute__((ext_vector_type(16)));
typedef unsigned u32x2 __attribute__((ext_vector_type(2)));
typedef unsigned u32x4 __attribute__((ext_vector_type(4)));
typedef __bf16 hbf16x2 __attribute__((ext_vector_type(2)));

#define DI __device__ __forceinline__

constexpr int T = 65536, TP = 32768;
constexpr float EPS = 1e-6f;
constexpr float LOG2E = 1.4426950408889634f;
constexpr float QSCALE_SWA = 0.125f * LOG2E;
constexpr float QSCALE_MLA = 0.10206207261596577f * LOG2E;
constexpr int NPHASE = 10;
constexpr int NTHR = 512;
constexpr int LDS_BYTES = 131072;

struct KArgs { const float* in[22]; float* out; unsigned char* ws; int ph_lo, ph_hi; };

struct Params {
    const float *x_p, *x_s, *p_p, *p_s;
    const float *g_mix, *w_in, *g_cq, *w_uq, *g_ckv, *w_ukv, *sink, *g_swa, *g_mla, *w_o, *g_ffn, *w_gate, *w_up, *w_down, *g_ple, *w_pg, *w_pp, *g_final;
    float* out;
    bf16_t *wt_in, *wt_uq, *wt_ukv, *wt_o, *wt_gu, *wt_d, *wt_pg, *wt_pp;
    float *rx, *rs_cq, *rs_ckv, *rs_oswa, *rs_omla, *rs_h1, *rs_h2, *rs_h3;
    f32x2* rope;
    bf16_t *xb, *cq, *ckv, *qm;
    bf16_t *o, *qs, *ks, *vst, *kr, *km, *vmt, *hb, *act, *pb, *ppb;
};

DI Params make_params(const KArgs& a) {
    Params p;
    const float* const* in = a.in;
    p.x_p = in[0]; p.x_s = in[1]; p.p_p = in[2]; p.p_s = in[3];
    p.g_mix = in[4]; p.w_in = in[5]; p.g_cq = in[6]; p.w_uq = in[7]; p.g_ckv = in[8]; p.w_ukv = in[9]; p.sink = in[10];
    p.g_swa = in[11]; p.g_mla = in[12]; p.w_o = in[13]; p.g_ffn = in[14]; p.w_gate = in[15]; p.w_up = in[16]; p.w_down = in[17];
    p.g_ple = in[18]; p.w_pg = in[19]; p.w_pp = in[20]; p.g_final = in[21];
    p.out = a.out;
    unsigned char* ws = a.ws; unsigned char* ob = (unsigned char*)a.out;
    constexpr size_t MB = (size_t)1 << 20;
    size_t off = 0;
    p.wt_in = (bf16_t*)(ws + off); off += (size_t)1280 * 1024 * 2;
    p.wt_uq = (bf16_t*)(ws + off); off += (size_t)768 * 256 * 2;
    p.wt_ukv = (bf16_t*)(ws + off); off += (size_t)1024 * 128 * 2;
    p.wt_o = (bf16_t*)(ws + off); off += (size_t)1024 * 1024 * 2;
    p.wt_gu = (bf16_t*)(ws + off); off += (size_t)5632 * 1024 * 2;
    p.wt_d = (bf16_t*)(ws + off); off += (size_t)1024 * 2816 * 2;
    p.wt_pg = (bf16_t*)(ws + off); off += (size_t)1024 * 1024 * 2;
    p.wt_pp = (bf16_t*)(ws + off); off += (size_t)1024 * 256 * 2;
    float* misc = (float*)(ws + 25 * MB);
    p.rx = misc; p.rs_cq = misc + T; p.rs_ckv = misc + 2 * T; p.rs_oswa = misc + 3 * T; p.rs_omla = misc + 4 * T; p.rs_h1 = misc + 5 * T; p.rs_h2 = misc + 6 * T; p.rs_h3 = misc + 7 * T;
    p.rope = (f32x2*)(ws + 27 * MB);
    p.o = (bf16_t*)(ws + 32 * MB); p.qs = (bf16_t*)(ws + 160 * MB); p.ks = (bf16_t*)(ws + 224 * MB); p.vst = (bf16_t*)(ws + 240 * MB);
    p.kr = (bf16_t*)(ws + 256 * MB); p.km = (bf16_t*)(ws + 264 * MB); p.vmt = (bf16_t*)(ws + 328 * MB);
    p.hb = (bf16_t*)(ws + 384 * MB); p.act = (bf16_t*)(ws + 32 * MB); p.pb = (bf16_t*)(ws + 32 * MB); p.ppb = (bf16_t*)(ws + 64 * MB);
    p.xb = (bf16_t*)(ob); p.cq = (bf16_t*)(ob + 128 * MB); p.ckv = (bf16_t*)(ob + 160 * MB); p.qm = (bf16_t*)(ob);
    return p;
}

DI unsigned cvt_pk(float lo, float hi) {
    f32x2 v = {lo, hi};
    hbf16x2 b = __builtin_convertvector(v, hbf16x2);
    return __builtin_bit_cast(unsigned, b);
}
DI void st_bf16x4(bf16_t* p, f32x4 v) { u32x2 w; w.x = cvt_pk(v[0], v[1]); w.y = cvt_pk(v[2], v[3]); *(u32x2*)p = w; }
DI bf16_t f2bf(float x) { unsigned u = __float_as_uint(x); u += 0x7fffu + ((u >> 16) & 1u); return (bf16_t)(u >> 16); }
DI void glds16(const void* g, void* l) { __builtin_amdgcn_global_load_lds((const unsigned*)g, (__attribute__((address_space(3))) unsigned*)l, 16, 0, 0); }
DI float fexp2(float x) { return __builtin_amdgcn_exp2f(x); }
DI void atomic_addf(float* p, float v) { unsafeAtomicAdd(p, v); }

constexpr int HT = 128 * 64;
DI int lds_byte(int r, int c) { const int st = (r >> 4) * 2 + (c >> 5), rr = r & 15, cc = c & 31, ob = rr * 64 + cc * 2; return st * 1024 + (ob ^ (((ob >> 9) & 1) << 5)); }
DI void stage_rc(int b, int& R, int& C) { const int st = b / 1024, sb = b % 1024, swz = sb ^ (((sb >> 9) & 1) << 5); R = (st >> 1) * 16 + swz / 64; C = (st & 1) * 32 + (swz % 64) / 2; }

DI void gemm256(f32x4 (&acc)[2][2][4][2], const bf16_t* A, int lda, const bf16_t* Bt, int ldb, int nt, unsigned char* smem, int tid_in) {
    bf16_t* shm = (bf16_t*)smem;
    int tid = tid_in; asm volatile("" : "+v"(tid));
    const int wid = __builtin_amdgcn_readfirstlane(tid >> 6), lane = tid & 63, wr = wid >> 2, wc = wid & 3, fr = lane & 15, fq = lane >> 4;
    int R0, C0, R1, C1; stage_rc(tid * 16, R0, C0); stage_rc(tid * 16 + 8192, R1, C1);
    const unsigned oa0 = (unsigned)(R0 * lda + C0), oa1 = (unsigned)(R1 * lda + C1), ob0 = (unsigned)(R0 * ldb + C0), ob1 = (unsigned)(R1 * ldb + C1);
    const size_t ha = (size_t)128 * lda, hb = (size_t)128 * ldb;
#define SA(b, h) (shm + ((b) * 2 + (h)) * HT)
#define SB(b, h) (shm + (4 + (b) * 2 + (h)) * HT)
#define STAGE_A(P, h, kt) do { const bf16_t* g_ = A + (h) * ha + (size_t)(kt) * 64; glds16(g_ + oa0, (char*)(P) + tid * 16); glds16(g_ + oa1, (char*)(P) + tid * 16 + 8192); } while (0)
#define STAGE_B(P, h, kt) do { const bf16_t* g_ = Bt + (h) * hb + (size_t)(kt) * 64; glds16(g_ + ob0, (char*)(P) + tid * 16); glds16(g_ + ob1, (char*)(P) + tid * 16 + 8192); } while (0)
#define LDA(dst, b, h) for (int m = 0; m < 4; ++m) for (int k = 0; k < 2; ++k) dst[m][k] = *reinterpret_cast<const bf16x8*>((char*)SA(b, h) + lds_byte(wr * 64 + m * 16 + fr, k * 32 + fq * 8))
#define LDB(dst, b, h) for (int n = 0; n < 2; ++n) for (int k = 0; k < 2; ++k) dst[n][k] = *reinterpret_cast<const bf16x8*>((char*)SB(b, h) + lds_byte(wc * 32 + n * 16 + fr, k * 32 + fq * 8))
#define MMA(ai, bj, At_, Bt_) do { __builtin_amdgcn_s_setprio(1); \
    for (int m = 0; m < 4; ++m) for (int n = 0; n < 2; ++n) for (int k = 0; k < 2; ++k) \
        acc[ai][bj][m][n] = __builtin_amdgcn_mfma_f32_16x16x32_bf16(Bt_[n][k], At_[m][k], acc[ai][bj][m][n], 0, 0, 0); \
    __builtin_amdgcn_s_setprio(0); } while (0)
#define WAIT_V(n) asm volatile("s_waitcnt vmcnt(" #n ")" ::: "memory")
#define WAIT_L(n) asm volatile("s_waitcnt lgkmcnt(" #n ")" ::: "memory")
#define BAR __builtin_amdgcn_s_barrier()
#define SCHED __builtin_amdgcn_sched_barrier(0)
    bf16x8 At[4][2], B0[2][2], B1[2][2];
    STAGE_B(SB(0, 0), 0, 0); STAGE_A(SA(0, 0), 0, 0);
    STAGE_B(SB(0, 1), 1, 0); STAGE_A(SA(0, 1), 1, 0);
    if (wr == 1) BAR;
    WAIT_V(4); BAR;
    STAGE_B(SB(1, 0), 0, 1); STAGE_A(SA(1, 0), 0, 1); STAGE_B(SB(1, 1), 1, 1);
    WAIT_V(6); BAR;
#pragma unroll 1
    for (int t = 0; t < nt - 2; t += 2) {
        LDB(B0, 0, 0); SCHED; LDA(At, 0, 0); STAGE_A(SA(1, 1), 1, t + 1);
        WAIT_L(8); BAR; WAIT_L(0); MMA(0, 0, At, B0); BAR; SCHED;
        LDB(B1, 0, 1); STAGE_B(SB(0, 0), 0, t + 2);
        BAR; WAIT_L(0); MMA(0, 1, At, B1); BAR;
        LDA(At, 0, 1); STAGE_A(SA(0, 0), 0, t + 2);
        BAR; WAIT_L(0); MMA(1, 0, At, B0); BAR; SCHED;
        STAGE_B(SB(0, 1), 1, t + 2);
        WAIT_V(6); BAR; MMA(1, 1, At, B1); BAR;
        LDB(B0, 1, 0); SCHED; LDA(At, 1, 0); STAGE_A(SA(0, 1), 1, t + 2);
        WAIT_L(8); BAR; WAIT_L(0); MMA(0, 0, At, B0); BAR; SCHED;
        LDB(B1, 1, 1); STAGE_B(SB(1, 0), 0, t + 3);
        BAR; WAIT_L(0); MMA(0, 1, At, B1); BAR;
        LDA(At, 1, 1); STAGE_A(SA(1, 0), 0, t + 3);
        BAR; WAIT_L(0); MMA(1, 0, At, B0); BAR; SCHED;
        STAGE_B(SB(1, 1), 1, t + 3);
        WAIT_V(6); BAR; MMA(1, 1, At, B1); BAR;
    }
    { LDB(B0, 0, 0); LDA(At, 0, 0); STAGE_A(SA(1, 1), 1, nt - 1);
      BAR; WAIT_L(0); MMA(0, 0, At, B0); BAR;
      LDB(B1, 0, 1); BAR; WAIT_L(0); MMA(0, 1, At, B1); BAR;
      LDA(At, 0, 1); WAIT_V(4); BAR; WAIT_L(0); MMA(1, 0, At, B0); MMA(1, 1, At, B1); BAR; }
    { LDB(B0, 1, 0); LDA(At, 1, 0); WAIT_V(2); BAR; WAIT_L(0); MMA(0, 0, At, B0); BAR;
      LDB(B1, 1, 1); WAIT_V(0); BAR; WAIT_L(0); MMA(0, 1, At, B1); BAR;
      LDA(At, 1, 1); BAR; WAIT_L(0); MMA(1, 0, At, B0); MMA(1, 1, At, B1); BAR; }
    if (wr == 0) BAR;
#undef SA
#undef SB
#undef STAGE_A
#undef STAGE_B
#undef LDA
#undef LDB
#undef MMA
#undef WAIT_V
#undef WAIT_L
#undef BAR
#undef SCHED
}

DI void tile_decode(int L, int nN, int& pm, int& pn) {
    const int q = (256 * nN) >> 3, xcd = L & 7, off = L >> 3;
    const int wgid = xcd * q + off, nig = 8 * nN, gid = wgid / nig, rem = wgid % nig;
    pm = gid * 8 + (rem & 7); pn = rem >> 3;
}

DI void zero_acc(f32x4 (&acc)[2][2][4][2]) {
#pragma unroll
    for (int a = 0; a < 2; ++a)
#pragma unroll
        for (int b = 0; b < 2; ++b)
#pragma unroll
            for (int m = 0; m < 4; ++m)
#pragma unroll
                for (int n = 0; n < 2; ++n) acc[a][b][m][n] = (f32x4){0.f, 0.f, 0.f, 0.f};
}
#define EPI_LANES() int fr = fr0, fq = fq0; asm volatile("" : "+v"(fr), "+v"(fq))
DI f32x4 ld_bf16x4(const bf16_t* p) { const u32x2 w = *(const u32x2*)p; return (f32x4){__uint_as_float(w.x << 16), __uint_as_float(w.x & 0xffff0000u), __uint_as_float(w.y << 16), __uint_as_float(w.y & 0xffff0000u)}; }
DI float sumsq4(f32x4 v) { return v[0] * v[0] + v[1] * v[1] + v[2] * v[2] + v[3] * v[3]; }

DI float row_sumsq_reduce(float s) { s += __shfl_xor(s, 16); s += __shfl_xor(s, 32); return s; }

DI void prep_tile(const float* src, const float* src_alt, int Nsrc, const float* gain, const float* gain_hi, bf16_t* dst, int K, int mode,
                  int kt, int nt, float* tl, int tid) {
    const int k0 = kt * 64, n0 = nt * 64, tx = tid & 63, ty = tid >> 6;
    const int n = n0 + tx;
    const float* s = src; int sc = n; bool valid = true;
    if (mode == 1) {
        const int tile = n >> 8, within = n & 255;
        sc = tile * 128 + (within & 127); s = (within >> 7) ? src_alt : src;
    } else valid = n < Nsrc;
    for (int i = ty; i < 64; i += 8) {
        const int k = k0 + i;
        float v = valid ? s[(size_t)k * Nsrc + sc] : 0.f;
        float g = 1.f;
        if (gain) g = (gain_hi && k >= 512) ? gain_hi[k - 512] : gain[k];
        tl[i * 65 + tx] = v * g;
    }
    __syncthreads();
    const int r = tid >> 3, kc = (tid & 7) * 8;
    u32x4 w0;
    w0.x = cvt_pk(tl[(kc + 0) * 65 + r], tl[(kc + 1) * 65 + r]); w0.y = cvt_pk(tl[(kc + 2) * 65 + r], tl[(kc + 3) * 65 + r]);
    w0.z = cvt_pk(tl[(kc + 4) * 65 + r], tl[(kc + 5) * 65 + r]); w0.w = cvt_pk(tl[(kc + 6) * 65 + r], tl[(kc + 7) * 65 + r]);
    *(u32x4*)(dst + (size_t)(n0 + r) * K + k0 + kc) = w0;
    __syncthreads();
}

__device__ void phase0(const Params& p, unsigned char* smem, int tid) {
    float* tl = (float*)smem;
    constexpr int C0 = 320, C1 = C0 + 48, C2 = C1 + 32, C3 = C2 + 256, C4 = C3 + 1408, C5 = C4 + 704, C6 = C5 + 256, C7 = C6 + 64;
    for (int i = blockIdx.x; i < C7; i += gridDim.x) {
        if (i < C0)      { const int j = i;      prep_tile(p.w_in, nullptr, 1184, p.g_mix, nullptr, p.wt_in, 1024, 0, j % 16, j / 16, tl, tid); }
        else if (i < C1) { const int j = i - C0; prep_tile(p.w_uq, nullptr, 768, p.g_cq, nullptr, p.wt_uq, 256, 0, j % 4, j / 4, tl, tid); }
        else if (i < C2) { const int j = i - C1; prep_tile(p.w_ukv, nullptr, 1024, p.g_ckv, nullptr, p.wt_ukv, 128, 0, j % 2, j / 2, tl, tid); }
        else if (i < C3) { const int j = i - C2; prep_tile(p.w_o, nullptr, 1024, p.g_swa, p.g_mla, p.wt_o, 1024, 0, j % 16, j / 16, tl, tid); }
        else if (i < C4) { const int j = i - C3; prep_tile(p.w_gate, p.w_up, 2816, p.g_ffn, nullptr, p.wt_gu, 1024, 1, j % 16, j / 16, tl, tid); }
        else if (i < C5) { const int j = i - C4; prep_tile(p.w_down, nullptr, 1024, nullptr, nullptr, p.wt_d, 2816, 0, j % 44, j / 44, tl, tid); }
        else if (i < C6) { const int j = i - C5; prep_tile(p.w_pg, nullptr, 1024, p.g_ple, nullptr, p.wt_pg, 1024, 0, j % 16, j / 16, tl, tid); }
        else             { const int j = i - C6; prep_tile(p.w_pp, nullptr, 1024, nullptr, nullptr, p.wt_pp, 256, 0, j % 4, j / 4, tl, tid); }
    }
    const int lane = tid & 63, gw = blockIdx.x * (NTHR / 64) + (tid >> 6), nw = gridDim.x * (NTHR / 64);
    for (int row = gw; row < T; row += nw) {
        const float* xr = row < TP ? p.x_p + (size_t)row * 1024 : p.x_s + (size_t)(row - TP) * 1024;
        f32x4 v[4]; float ss = 0.f;
#pragma unroll
        for (int i = 0; i < 4; ++i) { v[i] = *(const f32x4*)(xr + (i * 64 + lane) * 4); ss += sumsq4(v[i]); }
#pragma unroll
        for (int o = 32; o >= 1; o >>= 1) ss += __shfl_xor(ss, o);
        if (lane == 0) p.rx[row] = 1.0f / sqrtf(ss * (1.0f / 1024.0f) + EPS);
#pragma unroll
        for (int i = 0; i < 4; ++i) st_bf16x4(p.xb + (size_t)row * 1024 + (i * 64 + lane) * 4, v[i]);
    }
    const int gt = blockIdx.x * NTHR + tid, nt = gridDim.x * NTHR;
    for (int idx = gt; idx < 16384 * 16; idx += nt) {
        const int s = idx >> 4, i = idx & 15;
        const float inv = (float)pow(10000.0, -(double)i / 16.0);
        const float ang = (float)s * inv;
        const double a = (double)ang;
        p.rope[idx] = (f32x2){(float)cos(a), (float)sin(a)};
    }
    for (int idx = gt; idx < 7 * T; idx += nt) p.rs_cq[idx] = 0.f;
}

DI void seq_of_row(int row, int& S, int& s) { if (row < TP) { S = 16384; s = row & 16383; } else { S = 4096; s = row & 4095; } }

__device__ void phase1(const Params& p, unsigned char* smem, int tid) {
    const int wid = __builtin_amdgcn_readfirstlane(tid >> 6), lane = tid & 63, wr = wid >> 2, wc = wid & 3, fr0 = lane & 15, fq0 = lane >> 4;
    for (int L = blockIdx.x; L < 256 * 5; L += gridDim.x) {
        int pm, pn; tile_decode(L, 5, pm, pn);
        f32x4 acc[2][2][4][2]; zero_acc(acc);
        gemm256(acc, p.xb + (size_t)pm * 256 * 1024, 1024, p.wt_in + (size_t)pn * 256 * 1024, 1024, 16, smem, tid);
        { EPI_LANES();

#pragma unroll
        for (int ai = 0; ai < 2; ++ai)
#pragma unroll
            for (int m = 0; m < 4; ++m) {
                asm volatile("" ::: "memory");
                const int row = pm * 256 + ai * 128 + wr * 64 + m * 16 + fr;
                const float r = p.rx[row];
                int S, s; seq_of_row(row, S, s);
                const int ct = wc * 32 + 4 * fq;
                if (pn < 2) {
#pragma unroll
                    for (int bj = 0; bj < 2; ++bj)
#pragma unroll
                        for (int n = 0; n < 2; ++n) st_bf16x4(p.qs + (size_t)row * 512 + pn * 256 + bj * 128 + ct + n * 16, acc[ai][bj][m][n] * (r * QSCALE_SWA));
                } else if (pn == 2) {
#pragma unroll
                    for (int n = 0; n < 2; ++n) st_bf16x4(p.ks + (size_t)row * 128 + ct + n * 16, acc[ai][0][m][n] * r);
                    bf16_t* vb = p.vst + (size_t)(row - s) * 128 + s;
#pragma unroll
                    for (int n = 0; n < 2; ++n)
#pragma unroll
                        for (int j = 0; j < 4; ++j) vb[(size_t)(ct + n * 16 + j) * S] = f2bf(acc[ai][1][m][n][j] * r);
                } else if (pn == 3) {
                    float ss = 0.f;
#pragma unroll
                    for (int bj = 0; bj < 2; ++bj)
#pragma unroll
                        for (int n = 0; n < 2; ++n) { const f32x4 v = acc[ai][bj][m][n] * r; ss += sumsq4(v); st_bf16x4(p.cq + (size_t)row * 256 + bj * 128 + ct + n * 16, v); }
                    ss = row_sumsq_reduce(ss);
                    if (fq == 0) atomic_addf(p.rs_cq + row, ss);
                } else {
                    float ss = 0.f;
#pragma unroll
                    for (int n = 0; n < 2; ++n) { const f32x4 v = acc[ai][0][m][n] * r; ss += sumsq4(v); st_bf16x4(p.ckv + (size_t)row * 128 + ct + n * 16, v); }
                    ss = row_sumsq_reduce(ss);
                    if (fq == 0) atomic_addf(p.rs_ckv + row, ss);
                    if (wc == 0) {
                        const f32x4 x1 = acc[ai][1][m][0] * r, x2 = acc[ai][1][m][1] * r; f32x4 o1, o2;
#pragma unroll
                        for (int j = 0; j < 4; ++j) { const f32x2 cs = p.rope[s * 16 + 4 * fq + j]; o1[j] = x1[j] * cs.x - x2[j] * cs.y; o2[j] = x2[j] * cs.x + x1[j] * cs.y; }
                        st_bf16x4(p.kr + (size_t)row * 32 + 4 * fq, o1);
                        st_bf16x4(p.kr + (size_t)row * 32 + 16 + 4 * fq, o2);
                    }
                }
            } }
    }
}

__device__ void phase2(const Params& p, unsigned char* smem, int tid) {
    const int wid = __builtin_amdgcn_readfirstlane(tid >> 6), lane = tid & 63, wr = wid >> 2, wc = wid & 3, fr0 = lane & 15, fq0 = lane >> 4;
    for (int L = blockIdx.x; L < 256 * 7; L += gridDim.x) {
        if (L < 256 * 3) {
            int pm, pn; tile_decode(L, 3, pm, pn);
            f32x4 acc[2][2][4][2]; zero_acc(acc);
            gemm256(acc, p.cq + (size_t)pm * 256 * 256, 256, p.wt_uq + (size_t)pn * 256 * 256, 256, 4, smem, tid);
            { EPI_LANES();

#pragma unroll
            for (int ai = 0; ai < 2; ++ai)
#pragma unroll
                for (int m = 0; m < 4; ++m) {
                    asm volatile("" ::: "memory");
                    const int row = pm * 256 + ai * 128 + wr * 64 + m * 16 + fr;
                    const float r = QSCALE_MLA / sqrtf(p.rs_cq[row] * (1.0f / 256.0f) + EPS);
                    int S, s; seq_of_row(row, S, s);
#pragma unroll
                    for (int bj = 0; bj < 2; ++bj) {
                        const int c0 = pn * 256 + bj * 128 + wc * 32;
                        f32x4 x1 = acc[ai][bj][m][0] * r, x2 = acc[ai][bj][m][1] * r;
                        if (((c0 >> 5) % 3) == 2) {
                            f32x4 o1, o2;
#pragma unroll
                            for (int j = 0; j < 4; ++j) { const f32x2 cs = p.rope[s * 16 + 4 * fq + j]; o1[j] = x1[j] * cs.x - x2[j] * cs.y; o2[j] = x2[j] * cs.x + x1[j] * cs.y; }
                            x1 = o1; x2 = o2;
                        }
                        st_bf16x4(p.qm + (size_t)row * 768 + c0 + 4 * fq, x1);
                        st_bf16x4(p.qm + (size_t)row * 768 + c0 + 16 + 4 * fq, x2);
                    }
                } }
        } else {
            int pm, pn; tile_decode(L - 256 * 3, 4, pm, pn);
            f32x4 acc[2][2][4][2]; zero_acc(acc);
            gemm256(acc, p.ckv + (size_t)pm * 256 * 128, 128, p.wt_ukv + (size_t)pn * 256 * 128, 128, 2, smem, tid);
            { EPI_LANES();

#pragma unroll
            for (int ai = 0; ai < 2; ++ai)
#pragma unroll
                for (int m = 0; m < 4; ++m) {
                    asm volatile("" ::: "memory");
                    const int row = pm * 256 + ai * 128 + wr * 64 + m * 16 + fr;
                    const float r = 1.0f / sqrtf(p.rs_ckv[row] * (1.0f / 128.0f) + EPS);
                    int S, s; seq_of_row(row, S, s);
#pragma unroll
                    for (int bj = 0; bj < 2; ++bj) {
                        const int head = pn * 2 + bj;
                        if (wc < 2) {
#pragma unroll
                            for (int n = 0; n < 2; ++n) st_bf16x4(p.km + (size_t)row * 512 + head * 64 + wc * 32 + n * 16 + 4 * fq, acc[ai][bj][m][n] * r);
                        } else {
                            bf16_t* vb = p.vmt + (size_t)(row - s) * 512 + (size_t)head * 64 * S + s;
#pragma unroll
                            for (int n = 0; n < 2; ++n)
#pragma unroll
                                for (int j = 0; j < 4; ++j) vb[(size_t)((wc - 2) * 32 + n * 16 + 4 * fq + j) * S] = f2bf(acc[ai][bj][m][n][j] * r);
                        }
                    }
                } }
        }
    }
}

DI bf16x8 pack8(const f32x16& x, int s8) {
    u32x4 w;
    w.x = cvt_pk(x[s8 + 0], x[s8 + 1]); w.y = cvt_pk(x[s8 + 2], x[s8 + 3]); w.z = cvt_pk(x[s8 + 4], x[s8 + 5]); w.w = cvt_pk(x[s8 + 6], x[s8 + 7]);
    return __builtin_bit_cast(bf16x8, w);
}

template <bool SWA>
DI void attn_item(const Params& p, unsigned char* smem, int tid, int tok0, int S, int head, int qb) {
    constexpr int NQ = SWA ? 4 : 6;
    constexpr int STG = 20480;
    const int w = tid >> 6, lane = tid & 63, r = lane & 31, h = lane >> 5;
    const int krow = (r & 3) | ((r & 4) << 1) | ((r & 8) >> 1) | (r & 16);
    const int kswz = (krow >> 1) & 7, krswz = (krow >> 2) & 3, vswz = (r >> 1) & 7;
    const int qpos = qb * 256 + w * 32 + r;
    const int q_tok = tok0 + qpos;
    bf16x8 qf[NQ];
    {
        const bf16_t* qptr = SWA ? p.qs + (size_t)q_tok * 512 + head * 64 : p.qm + (size_t)q_tok * 768 + head * 96;
#pragma unroll
        for (int ks = 0; ks < NQ; ++ks) qf[ks] = *(const bf16x8*)(qptr + ks * 16 + h * 8);
    }
    const int ldk = SWA ? 128 : 512;
    const bf16_t* kn_base = SWA ? p.ks + (size_t)tok0 * 128 + (head >> 2) * 64 : p.km + (size_t)tok0 * 512 + head * 64;
    const bf16_t* kr_base = p.kr + (size_t)tok0 * 32;
    const bf16_t* vt_base = SWA ? p.vst + (size_t)tok0 * 128 + (size_t)(head >> 2) * 64 * S : p.vmt + (size_t)tok0 * 512 + (size_t)head * 64 * S;
    int kt0 = 0, kt1 = S >> 6;
    if (SWA) { int lo = qb * 256 - 128, hi = qb * 256 + 384; lo = lo < 0 ? 0 : lo; hi = hi > S ? S : hi; kt0 = lo >> 6; kt1 = hi >> 6; }
    float slope2 = 0.f, mrun = -1e30f, lrun = 0.f;
    if (SWA) { slope2 = exp2f(-(float)(head + 1)) * LOG2E; mrun = p.sink[head] * LOG2E; lrun = h == 0 ? 1.f : 0.f; }

    f32x16 o0, o1;
#pragma unroll
    for (int i = 0; i < 16; ++i) { o0[i] = 0.f; o1[i] = 0.f; }

    auto stage = [&](int kt, int buf) {
        unsigned char* sb = smem + buf * STG;
        const int key0 = kt * 64;
        const int row = tid >> 3, ch = (tid & 7) ^ ((tid >> 4) & 7);
        glds16(kn_base + (size_t)(key0 + row) * ldk + ch * 8, sb + tid * 16);
        glds16(vt_base + (size_t)row * S + key0 + ch * 8, sb + 8192 + tid * 16);
        if (!SWA && tid < 256) {
            const int row4 = tid >> 2, c4 = (tid & 3) ^ ((row4 >> 2) & 3);
            glds16(kr_base + (size_t)(key0 + row4) * 32 + c4 * 8, sb + 16384 + tid * 16);
        }
    };

    stage(kt0, 0);
    for (int kt = kt0; kt < kt1; ++kt) {
        const int buf = (kt - kt0) & 1;
        asm volatile("s_waitcnt vmcnt(0)" ::: "memory");
        __syncthreads();
        if (kt + 1 < kt1) stage(kt + 1, buf ^ 1);
        const int key0 = kt * 64;
        bool active = true;
        if (SWA) { const int q0w = qb * 256 + w * 32; active = !(key0 > q0w + 31 + 128 || key0 + 63 < q0w - 128); }
        if (active) {
            const unsigned char* sb = smem + buf * STG;
            f32x16 s0, s1;
#pragma unroll
            for (int i = 0; i < 16; ++i) { s0[i] = 0.f; s1[i] = 0.f; }
#pragma unroll
            for (int ks = 0; ks < 4; ++ks) {
                const int co = ((2 * ks + h) ^ kswz) * 16;
                const bf16x8 a0 = *(const bf16x8*)(sb + krow * 128 + co);
                const bf16x8 a1 = *(const bf16x8*)(sb + (32 + krow) * 128 + co);
                s0 = __builtin_amdgcn_mfma_f32_32x32x16_bf16(a0, qf[ks], s0, 0, 0, 0);
                s1 = __builtin_amdgcn_mfma_f32_32x32x16_bf16(a1, qf[ks], s1, 0, 0, 0);
            }
            if (!SWA) {
#pragma unroll
                for (int ks = 0; ks < 2; ++ks) {
                    const int co = ((2 * ks + h) ^ krswz) * 16;
                    const bf16x8 a0 = *(const bf16x8*)(sb + 16384 + krow * 64 + co);
                    const bf16x8 a1 = *(const bf16x8*)(sb + 16384 + (32 + krow) * 64 + co);
                    s0 = __builtin_amdgcn_mfma_f32_32x32x16_bf16(a0, qf[NQ - 2 + ks], s0, 0, 0, 0);
                    s1 = __builtin_amdgcn_mfma_f32_32x32x16_bf16(a1, qf[NQ - 2 + ks], s1, 0, 0, 0);
                }
            }
            if (SWA) {
#pragma unroll
                for (int i = 0; i < 16; ++i) {
                    const int kidx = (i & 3) + 4 * ((i >> 2) & 1) + 8 * h + 16 * ((i >> 3) & 1);
                    const int d0 = key0 + kidx - qpos, d1 = d0 + 32;
                    const int a0 = d0 < 0 ? -d0 : d0, a1 = d1 < 0 ? -d1 : d1;
                    s0[i] = a0 <= 128 ? s0[i] - slope2 * (float)a0 : -1e30f;
                    s1[i] = a1 <= 128 ? s1[i] - slope2 * (float)a1 : -1e30f;
                }
            }
            float mx = fmaxf(s0[0], s1[0]);
#pragma unroll
            for (int i = 1; i < 16; ++i) mx = fmaxf(fmaxf(mx, s0[i]), s1[i]);
            mx = fmaxf(mx, __shfl_xor(mx, 32));
            if (__any(mx > mrun + 6.0f)) {
                const float mnew = fmaxf(mrun, mx);
                const float alpha = fexp2(mrun - mnew);
                mrun = mnew; lrun *= alpha;
#pragma unroll
                for (int i = 0; i < 16; ++i) { o0[i] *= alpha; o1[i] *= alpha; }
            }
            float ps = 0.f;
#pragma unroll
            for (int i = 0; i < 16; ++i) { s0[i] = fexp2(s0[i] - mrun); s1[i] = fexp2(s1[i] - mrun); ps += s0[i] + s1[i]; }
            lrun += ps;
            const unsigned char* sv = sb + 8192 + r * 128;
#pragma unroll
            for (int blk = 0; blk < 2; ++blk)
#pragma unroll
                for (int s = 0; s < 2; ++s) {
                    const bf16x8 pf = pack8(blk ? s1 : s0, 8 * s);
                    const int co = ((4 * blk + 2 * s + h) ^ vswz) * 16;
                    const bf16x8 v0 = *(const bf16x8*)(sv + co);
                    const bf16x8 v1 = *(const bf16x8*)(sv + 32 * 128 + co);
                    o0 = __builtin_amdgcn_mfma_f32_32x32x16_bf16(v0, pf, o0, 0, 0, 0);
                    o1 = __builtin_amdgcn_mfma_f32_32x32x16_bf16(v1, pf, o1, 0, 0, 0);
                }
        }
    }
    const float l = lrun + __shfl_xor(lrun, 32);
    const float inv = 1.0f / l;
    bf16_t* orow = p.o + (size_t)q_tok * 1024 + (SWA ? 0 : 512) + head * 64;
    float ss = 0.f;
#pragma unroll
    for (int g = 0; g < 4; ++g) {
        const f32x4 v0 = {o0[4 * g] * inv, o0[4 * g + 1] * inv, o0[4 * g + 2] * inv, o0[4 * g + 3] * inv};
        const f32x4 v1 = {o1[4 * g] * inv, o1[4 * g + 1] * inv, o1[4 * g + 2] * inv, o1[4 * g + 3] * inv};
        ss += sumsq4(v0) + sumsq4(v1);
        st_bf16x4(orow + 8 * g + 4 * h, v0);
        st_bf16x4(orow + 32 + 8 * g + 4 * h, v1);
    }
    ss += __shfl_xor(ss, 32);
    if (h == 0) atomic_addf((SWA ? p.rs_oswa : p.rs_omla) + q_tok, ss);
    __syncthreads();
}

__device__ void phase3(const Params& p, unsigned char* smem, int tid) {
    for (int I = blockIdx.x; I < 4096; I += gridDim.x) {
        if (I < 1024) {
            const int rnd = I >> 8, B = I & 255, xcd = B & 7, slot = B >> 3;
            const int combo = xcd + 8 * (rnd >> 1), qb = (rnd & 1) * 32 + slot;
            attn_item<false>(p, smem, tid, (combo >> 3) * 16384, 16384, combo & 7, qb);
        } else if (I < 2048) {
            const int J = I - 1024, rnd = J >> 8, B = J & 255, xcd = B & 7, slot = B >> 3;
            const int combo = xcd * 8 + rnd * 2 + (slot >> 4), qb = slot & 15;
            attn_item<false>(p, smem, tid, TP + (combo >> 3) * 4096, 4096, combo & 7, qb);
        } else {
            const int J = I - 2048, head = J >> 8, tb = (J & 255) * 256;
            int tok0, S;
            if (tb < TP) { tok0 = (tb >> 14) << 14; S = 16384; } else { tok0 = TP + (((tb - TP) >> 12) << 12); S = 4096; }
            attn_item<true>(p, smem, tid, tok0, S, head, (tb - tok0) >> 8);
        }
    }
}

__device__ void phase4(const Params& p, unsigned char* smem, int tid) {
    const int wid = __builtin_amdgcn_readfirstlane(tid >> 6), lane = tid & 63, wr = wid >> 2, wc = wid & 3, fr0 = lane & 15, fq0 = lane >> 4;
    for (int L = blockIdx.x; L < 256 * 4; L += gridDim.x) {
        int pm, pn; tile_decode(L, 4, pm, pn);
        f32x4 acc[2][2][4][2]; zero_acc(acc);
        const bf16_t* A = p.o + (size_t)pm * 256 * 1024; const bf16_t* B = p.wt_o + (size_t)pn * 256 * 1024;
        gemm256(acc, A, 1024, B, 1024, 8, smem, tid);
        { EPI_LANES();

#pragma unroll
        for (int ai = 0; ai < 2; ++ai)
#pragma unroll
            for (int m = 0; m < 4; ++m) {
                asm volatile("" ::: "memory");
                const int row = pm * 256 + ai * 128 + wr * 64 + m * 16 + fr;
                const float f = sqrtf((p.rs_omla[row] * (1.0f / 512.0f) + EPS) / (p.rs_oswa[row] * (1.0f / 512.0f) + EPS));
#pragma unroll
                for (int bj = 0; bj < 2; ++bj)
#pragma unroll
                    for (int n = 0; n < 2; ++n) acc[ai][bj][m][n] *= f;
            } }
        gemm256(acc, A + 512, 1024, B + 512, 1024, 8, smem, tid);
        { EPI_LANES();

#pragma unroll
        for (int ai = 0; ai < 2; ++ai)
#pragma unroll
            for (int m = 0; m < 4; ++m) {
                asm volatile("" ::: "memory");
                const int row = pm * 256 + ai * 128 + wr * 64 + m * 16 + fr;
                const float rm = 1.0f / sqrtf(p.rs_omla[row] * (1.0f / 512.0f) + EPS);
                const float* xr = row < TP ? p.x_p + (size_t)row * 1024 : p.x_s + (size_t)(row - TP) * 1024;
                float ss = 0.f;
#pragma unroll
                for (int bj = 0; bj < 2; ++bj)
#pragma unroll
                    for (int n = 0; n < 2; ++n) {
                        const int col = pn * 256 + bj * 128 + wc * 32 + n * 16 + 4 * fq;
                        const f32x4 hv = *(const f32x4*)(xr + col) + acc[ai][bj][m][n] * rm;
                        ss += sumsq4(hv);
                        st_bf16x4(p.hb + (size_t)row * 1024 + col, hv);
                    }
                ss = row_sumsq_reduce(ss);
                if (fq == 0) atomic_addf(p.rs_h1 + row, ss);
            } }
    }
}

__device__ void phase5(const Params& p, unsigned char* smem, int tid) {
    const int wid = __builtin_amdgcn_readfirstlane(tid >> 6), lane = tid & 63, wr = wid >> 2, wc = wid & 3, fr0 = lane & 15, fq0 = lane >> 4;
    for (int L = blockIdx.x; L < 256 * 22; L += gridDim.x) {
        int pm, pn; tile_decode(L, 22, pm, pn);
        f32x4 acc[2][2][4][2]; zero_acc(acc);
        gemm256(acc, p.hb + (size_t)pm * 256 * 1024, 1024, p.wt_gu + (size_t)pn * 256 * 1024, 1024, 16, smem, tid);
        { EPI_LANES();

#pragma unroll
        for (int ai = 0; ai < 2; ++ai)
#pragma unroll
            for (int m = 0; m < 4; ++m) {
                asm volatile("" ::: "memory");
                const int row = pm * 256 + ai * 128 + wr * 64 + m * 16 + fr;
                const float r = 1.0f / sqrtf(p.rs_h1[row] * (1.0f / 1024.0f) + EPS);
#pragma unroll
                for (int n = 0; n < 2; ++n) {
                    f32x4 a;
#pragma unroll
                    for (int j = 0; j < 4; ++j) { const float g = acc[ai][0][m][n][j] * r, u = acc[ai][1][m][n][j] * r; a[j] = g * u / (1.0f + __expf(-g)); }
                    st_bf16x4(p.act + (size_t)row * 2816 + pn * 128 + wc * 32 + n * 16 + 4 * fq, a);
                }
            } }
    }
}

__device__ void phase6(const Params& p, unsigned char* smem, int tid) {
    const int wid = __builtin_amdgcn_readfirstlane(tid >> 6), lane = tid & 63, wr = wid >> 2, wc = wid & 3, fr0 = lane & 15, fq0 = lane >> 4;
    for (int L = blockIdx.x; L < 256 * 4; L += gridDim.x) {
        int pm, pn; tile_decode(L, 4, pm, pn);
        f32x4 acc[2][2][4][2]; zero_acc(acc);
        gemm256(acc, p.act + (size_t)pm * 256 * 2816, 2816, p.wt_d + (size_t)pn * 256 * 2816, 2816, 44, smem, tid);
        { EPI_LANES();

#pragma unroll
        for (int ai = 0; ai < 2; ++ai)
#pragma unroll
            for (int m = 0; m < 4; ++m) {
                asm volatile("" ::: "memory");
                const int row = pm * 256 + ai * 128 + wr * 64 + m * 16 + fr;
                float ss = 0.f;
#pragma unroll
                for (int bj = 0; bj < 2; ++bj)
#pragma unroll
                    for (int n = 0; n < 2; ++n) {
                        const int col = pn * 256 + bj * 128 + wc * 32 + n * 16 + 4 * fq;
                        bf16_t* hp = p.hb + (size_t)row * 1024 + col;
                        const f32x4 hv = ld_bf16x4(hp) + acc[ai][bj][m][n];
                        ss += sumsq4(hv);
                        st_bf16x4(hp, hv);
                    }
                ss = row_sumsq_reduce(ss);
                if (fq == 0) atomic_addf(p.rs_h2 + row, ss);
            } }
    }
}

__device__ void phase_pb(const Params& p, int tid) {
    const int gt = blockIdx.x * NTHR + tid, nt = gridDim.x * NTHR;
    for (int idx = gt; idx < T * 64; idx += nt) {
        const int row = idx >> 6, c = (idx & 63) * 4;
        const float* pr = row < TP ? p.p_p + (size_t)row * 256 : p.p_s + (size_t)(row - TP) * 256;
        st_bf16x4(p.pb + (size_t)row * 256 + c, *(const f32x4*)(pr + c));
    }
}

__device__ void phase8(const Params& p, unsigned char* smem, int tid) {
    const int wid = __builtin_amdgcn_readfirstlane(tid >> 6), lane = tid & 63, wr = wid >> 2, wc = wid & 3, fr0 = lane & 15, fq0 = lane >> 4;
    for (int L = blockIdx.x; L < 256 * 4; L += gridDim.x) {
        int pm, pn; tile_decode(L, 4, pm, pn);
        f32x4 acc[2][2][4][2]; zero_acc(acc);
        gemm256(acc, p.pb + (size_t)pm * 256 * 256, 256, p.wt_pp + (size_t)pn * 256 * 256, 256, 4, smem, tid);
        { EPI_LANES();

#pragma unroll
        for (int ai = 0; ai < 2; ++ai)
#pragma unroll
            for (int m = 0; m < 4; ++m) {
                asm volatile("" ::: "memory");
                const int row = pm * 256 + ai * 128 + wr * 64 + m * 16 + fr;
#pragma unroll
                for (int bj = 0; bj < 2; ++bj)
#pragma unroll
                    for (int n = 0; n < 2; ++n) st_bf16x4(p.ppb + (size_t)row * 1024 + pn * 256 + bj * 128 + wc * 32 + n * 16 + 4 * fq, acc[ai][bj][m][n]);
            } }
        zero_acc(acc);
        gemm256(acc, p.hb + (size_t)pm * 256 * 1024, 1024, p.wt_pg + (size_t)pn * 256 * 1024, 1024, 16, smem, tid);
        { EPI_LANES();

#pragma unroll
        for (int ai = 0; ai < 2; ++ai)
#pragma unroll
            for (int m = 0; m < 4; ++m) {
                asm volatile("" ::: "memory");
                const int row = pm * 256 + ai * 128 + wr * 64 + m * 16 + fr;
                const float r = 1.0f / sqrtf(p.rs_h2[row] * (1.0f / 1024.0f) + EPS);
                float ss = 0.f;
#pragma unroll
                for (int bj = 0; bj < 2; ++bj)
#pragma unroll
                    for (int n = 0; n < 2; ++n) {
                        const int col = pn * 256 + bj * 128 + wc * 32 + n * 16 + 4 * fq;
                        float* op = p.out + (size_t)row * 1024 + col;
                        f32x4 hv = ld_bf16x4(p.hb + (size_t)row * 1024 + col);
                        const f32x4 pp = ld_bf16x4(p.ppb + (size_t)row * 1024 + col);
#pragma unroll
                        for (int j = 0; j < 4; ++j) { const float gt = 1.0f / (1.0f + __expf(-acc[ai][bj][m][n][j] * r)); hv[j] += gt * pp[j]; }
                        ss += sumsq4(hv);
                        *(f32x4*)op = hv;
                    }
                ss = row_sumsq_reduce(ss);
                if (fq == 0) atomic_addf(p.rs_h3 + row, ss);
            } }
    }
}

__device__ void phase9(const Params& p, int tid) {
    const int gt = blockIdx.x * NTHR + tid, nt = gridDim.x * NTHR;
    for (int idx = gt; idx < T * 256; idx += nt) {
        const int row = idx >> 8, c = (idx & 255) * 4;
        const float r = 1.0f / sqrtf(p.rs_h3[row] * (1.0f / 1024.0f) + EPS);
        float* op = p.out + (size_t)row * 1024 + c;
        const f32x4 g = *(const f32x4*)(p.g_final + c);
        *(f32x4*)op = *(const f32x4*)op * r * g;
    }
}

__global__ void __launch_bounds__(512, 2) mega(KArgs ka) {
    extern __shared__ __attribute__((aligned(16))) unsigned char smem[];
    const int tid = threadIdx.x;
    const int lo = ka.ph_lo, hi = ka.ph_hi;
#define RUN_PHASE(N, CALL) if (lo <= N && N < hi) { { const Params p = make_params(ka); CALL; } if (N + 1 < hi) cg::this_grid().sync(); }
#define RUN_PRE(N, CALL) if (N < PREFIX_K) { { const Params p = make_params(ka); CALL; } cg::this_grid().sync(); }
#if PREFIX_K > 0
    RUN_PRE(0, phase0(p, smem, tid))
    RUN_PRE(1, phase1(p, smem, tid))
    RUN_PRE(2, phase2(p, smem, tid))
    RUN_PRE(3, phase3(p, smem, tid))
    RUN_PRE(4, phase4(p, smem, tid))
    RUN_PRE(5, phase5(p, smem, tid))
    RUN_PRE(6, phase6(p, smem, tid))
#endif
    RUN_PHASE(0, phase0(p, smem, tid))
    RUN_PHASE(1, phase1(p, smem, tid))
    RUN_PHASE(2, phase2(p, smem, tid))
    RUN_PHASE(3, phase3(p, smem, tid))
    RUN_PHASE(4, phase4(p, smem, tid))
    RUN_PHASE(5, phase5(p, smem, tid))
    RUN_PHASE(6, phase6(p, smem, tid))
    RUN_PHASE(7, phase_pb(p, tid))
    RUN_PHASE(8, phase8(p, smem, tid))
    RUN_PHASE(9, phase9(p, tid))
#undef RUN_PRE
#undef RUN_PHASE
}

extern "C" void kernel_launch(void* const* d_in, const int* in_sizes, int n_in, void* d_out, int out_size, void* d_ws, size_t ws_size, hipStream_t stream) {
    static int grid = 0;
    if (grid == 0) {
        int dev = 0, cus = 0, per_cu = 0;
        (void)hipGetDevice(&dev);
        (void)hipDeviceGetAttribute(&cus, hipDeviceAttributeMultiprocessorCount, dev);
        (void)hipFuncSetAttribute((const void*)mega, hipFuncAttributeMaxDynamicSharedMemorySize, LDS_BYTES);
        (void)hipOccupancyMaxActiveBlocksPerMultiprocessor(&per_cu, (const void*)mega, NTHR, LDS_BYTES);
        if (per_cu < 1) fprintf(stderr, "kernel_launch: occupancy query reports %d blocks per CU\n", per_cu);
        grid = cus;
        if (ws_size < ((size_t)512 << 20)) fprintf(stderr, "kernel_launch: workspace too small (%zu)\n", ws_size);
    }
    KArgs p{};
    for (int i = 0; i < 22; ++i) p.in[i] = (const float*)d_in[i];
    p.out = (float*)d_out; p.ws = (unsigned char*)d_ws;
#if MULTI_LAUNCH
    for (int ph = 0; ph < NPHASE; ++ph) {
        p.ph_lo = ph; p.ph_hi = ph + 1;
        hipLaunchKernelGGL(mega, dim3(grid), dim3(NTHR), LDS_BYTES, stream, p);
    }
#else
    p.ph_lo = 0; p.ph_hi = NPHASE;
    void* args[] = {&p};
    hipError_t e = hipLaunchCooperativeKernel((const void*)mega, dim3(grid), dim3(NTHR), args, LDS_BYTES, stream);
    if (e != hipSuccess) fprintf(stderr, "cooperative launch failed: %s (grid %d)\n", hipGetErrorString(e), grid);
#endif
}
```

```cpp
#include <hip/hip_runtime.h>
#include <hip/hip_cooperative_groups.h>
#include <cstdio>
#include <cstdint>
namespace cg = cooperative_groups;

#ifndef PREFIX_K
#define PREFIX_K 0
#endif
#ifndef PROBE_V
#define PROBE_V 0
#endif
#ifndef MULTI_LAUNCH
#define MULTI_LAUNCH 0
#endif

typedef unsigned short bf16_t;
typedef short bf16x8 __attribute__((ext_vector_type(8)));
typedef float f32x2 __attribute__((ext_vector_type(2)));
typedef float f32x4 __attribute__((ext_vector_type(4)));
typedef float f32x16 __attribute__((ext_vector_type(16)));
typedef unsigned u32x2 __attribute__((ext_vector_type(2)));
typedef unsigned u32x4 __attribute__((ext_vector_type(4)));
typedef __bf16 hbf16x2 __attribute__((ext_vector_type(2)));

#define DI __device__ __forceinline__

constexpr int T = 65536, TP = 32768;
constexpr float EPS = 1e-6f;
constexpr float LOG2E = 1.4426950408889634f;
constexpr float QSCALE_SWA = 0.125f * LOG2E;
constexpr float QSCALE_MLA = 0.10206207261596577f * LOG2E;
constexpr int NPHASE = 10;
constexpr int NTHR = 512;
constexpr int LDS_BYTES = 131072;

struct KArgs { const float* in[22]; float* out; unsigned char* ws; int ph_lo, ph_hi; };

struct Params {
    const float *x_p, *x_s, *p_p, *p_s;
    const float *g_mix, *w_in, *g_cq, *w_uq, *g_ckv, *w_ukv, *sink, *g_swa, *g_mla, *w_o, *g_ffn, *w_gate, *w_up, *w_down, *g_ple, *w_pg, *w_pp, *g_final;
    float* out;
    bf16_t *wt_in, *wt_uq, *wt_ukv, *wt_o, *wt_gu, *wt_d, *wt_pg, *wt_pp;
    float *rx, *rs_cq, *rs_ckv, *rs_oswa, *rs_omla, *rs_h1, *rs_h2, *rs_h3;
    f32x2* rope;
    bf16_t *xb, *cq, *ckv, *qm;
    bf16_t *o, *qs, *ks, *vst, *kr, *km, *vmt, *hb, *act, *pb, *ppb;
};

DI Params make_params(const KArgs& a) {
    Params p;
    const float* const* in = a.in;
    p.x_p = in[0]; p.x_s = in[1]; p.p_p = in[2]; p.p_s = in[3];
    p.g_mix = in[4]; p.w_in = in[5]; p.g_cq = in[6]; p.w_uq = in[7]; p.g_ckv = in[8]; p.w_ukv = in[9]; p.sink = in[10];
    p.g_swa = in[11]; p.g_mla = in[12]; p.w_o = in[13]; p.g_ffn = in[14]; p.w_gate = in[15]; p.w_up = in[16]; p.w_down = in[17];
    p.g_ple = in[18]; p.w_pg = in[19]; p.w_pp = in[20]; p.g_final = in[21];
    p.out = a.out;
    unsigned char* ws = a.ws; unsigned char* ob = (unsigned char*)a.out;
    constexpr size_t MB = (size_t)1 << 20;
    size_t off = 0;
    p.wt_in = (bf16_t*)(ws + off); off += (size_t)1280 * 1024 * 2;
    p.wt_uq = (bf16_t*)(ws + off); off += (size_t)768 * 256 * 2;
    p.wt_ukv = (bf16_t*)(ws + off); off += (size_t)1024 * 128 * 2;
    p.wt_o = (bf16_t*)(ws + off); off += (size_t)1024 * 1024 * 2;
    p.wt_gu = (bf16_t*)(ws + off); off += (size_t)5632 * 1024 * 2;
    p.wt_d = (bf16_t*)(ws + off); off += (size_t)1024 * 2816 * 2;
    p.wt_pg = (bf16_t*)(ws + off); off += (size_t)1024 * 1024 * 2;
    p.wt_pp = (bf16_t*)(ws + off); off += (size_t)1024 * 256 * 2;
    float* misc = (float*)(ws + 25 * MB);
    p.rx = misc; p.rs_cq = misc + T; p.rs_ckv = misc + 2 * T; p.rs_oswa = misc + 3 * T; p.rs_omla = misc + 4 * T; p.rs_h1 = misc + 5 * T; p.rs_h2 = misc + 6 * T; p.rs_h3 = misc + 7 * T;
    p.rope = (f32x2*)(ws + 27 * MB);
    p.o = (bf16_t*)(ws + 32 * MB); p.qs = (bf16_t*)(ws + 160 * MB); p.ks = (bf16_t*)(ws + 224 * MB); p.vst = (bf16_t*)(ws + 240 * MB);
    p.kr = (bf16_t*)(ws + 256 * MB); p.km = (bf16_t*)(ws + 264 * MB); p.vmt = (bf16_t*)(ws + 328 * MB);
    p.hb = (bf16_t*)(ws + 384 * MB); p.act = (bf16_t*)(ws + 32 * MB); p.pb = (bf16_t*)(ws + 32 * MB); p.ppb = (bf16_t*)(ws + 64 * MB);
    p.xb = (bf16_t*)(ob); p.cq = (bf16_t*)(ob + 128 * MB); p.ckv = (bf16_t*)(ob + 160 * MB); p.qm = (bf16_t*)(ob);
    return p;
}

DI unsigned cvt_pk(float lo, float hi) {
    f32x2 v = {lo, hi};
    hbf16x2 b = __builtin_convertvector(v, hbf16x2);
    return __builtin_bit_cast(unsigned, b);
}
DI void st_bf16x4(bf16_t* p, f32x4 v) { u32x2 w; w.x = cvt_pk(v[0], v[1]); w.y = cvt_pk(v[2], v[3]); *(u32x2*)p = w; }
DI bf16_t f2bf(float x) { unsigned u = __float_as_uint(x); u += 0x7fffu + ((u >> 16) & 1u); return (bf16_t)(u >> 16); }
DI void glds16(const void* g, void* l) { __builtin_amdgcn_global_load_lds((const unsigned*)g, (__attribute__((address_space(3))) unsigned*)l, 16, 0, 0); }
DI float fexp2(float x) { return __builtin_amdgcn_exp2f(x); }
DI void atomic_addf(float* p, float v) { unsafeAtomicAdd(p, v); }

constexpr int HT = 128 * 64;
DI int lds_byte(int r, int c) { const int st = (r >> 4) * 2 + (c >> 5), rr = r & 15, cc = c & 31, ob = rr * 64 + cc * 2; return st * 1024 + (ob ^ (((ob >> 9) & 1) << 5)); }
DI void stage_rc(int b, int& R, int& C) { const int st = b / 1024, sb = b % 1024, swz = sb ^ (((sb >> 9) & 1) << 5); R = (st >> 1) * 16 + swz / 64; C = (st & 1) * 32 + (swz % 64) / 2; }

DI void gemm256(f32x4 (&acc)[2][2][4][2], const bf16_t* A, int lda, const bf16_t* Bt, int ldb, int nt, unsigned char* smem, int tid_in) {
    bf16_t* shm = (bf16_t*)smem;
    int tid = tid_in; asm volatile("" : "+v"(tid));
    const int wid = __builtin_amdgcn_readfirstlane(tid >> 6), lane = tid & 63, wr = wid >> 2, wc = wid & 3, fr = lane & 15, fq = lane >> 4;
    int R0, C0, R1, C1; stage_rc(tid * 16, R0, C0); stage_rc(tid * 16 + 8192, R1, C1);
    const unsigned oa0 = (unsigned)(R0 * lda + C0), oa1 = (unsigned)(R1 * lda + C1), ob0 = (unsigned)(R0 * ldb + C0), ob1 = (unsigned)(R1 * ldb + C1);
    const size_t ha = (size_t)128 * lda, hb = (size_t)128 * ldb;
#define SA(b, h) (shm + ((b) * 2 + (h)) * HT)
#define SB(b, h) (shm + (4 + (b) * 2 + (h)) * HT)
#define STAGE_A(P, h, kt) do { const bf16_t* g_ = A + (h) * ha + (size_t)(kt) * 64; glds16(g_ + oa0, (char*)(P) + tid * 16); glds16(g_ + oa1, (char*)(P) + tid * 16 + 8192); } while (0)
#define STAGE_B(P, h, kt) do { const bf16_t* g_ = Bt + (h) * hb + (size_t)(kt) * 64; glds16(g_ + ob0, (char*)(P) + tid * 16); glds16(g_ + ob1, (char*)(P) + tid * 16 + 8192); } while (0)
#define LDA(dst, b, h) for (int m = 0; m < 4; ++m) for (int k = 0; k < 2; ++k) dst[m][k] = *reinterpret_cast<const bf16x8*>((char*)SA(b, h) + lds_byte(wr * 64 + m * 16 + fr, k * 32 + fq * 8))
#define LDB(dst, b, h) for (int n = 0; n < 2; ++n) for (int k = 0; k < 2; ++k) dst[n][k] = *reinterpret_cast<const bf16x8*>((char*)SB(b, h) + lds_byte(wc * 32 + n * 16 + fr, k * 32 + fq * 8))
#define MMA(ai, bj, At_, Bt_) do { __builtin_amdgcn_s_setprio(1); \
    for (int m = 0; m < 4; ++m) for (int n = 0; n < 2; ++n) for (int k = 0; k < 2; ++k) \
        acc[ai][bj][m][n] = __builtin_amdgcn_mfma_f32_16x16x32_bf16(Bt_[n][k], At_[m][k], acc[ai][bj][m][n], 0, 0, 0); \
    __builtin_amdgcn_s_setprio(0); } while (0)
#define WAIT_V(n) asm volatile("s_waitcnt vmcnt(" #n ")" ::: "memory")
#define WAIT_L(n) asm volatile("s_waitcnt lgkmcnt(" #n ")" ::: "memory")
#define BAR __builtin_amdgcn_s_barrier()
#define SCHED __builtin_amdgcn_sched_barrier(0)
    bf16x8 At[4][2], B0[2][2], B1[2][2];
    STAGE_B(SB(0, 0), 0, 0); STAGE_A(SA(0, 0), 0, 0);
    STAGE_B(SB(0, 1), 1, 0); STAGE_A(SA(0, 1), 1, 0);
    if (wr == 1) BAR;
    WAIT_V(4); BAR;
    STAGE_B(SB(1, 0), 0, 1); STAGE_A(SA(1, 0), 0, 1); STAGE_B(SB(1, 1), 1, 1);
    WAIT_V(6); BAR;
#pragma unroll 1
    for (int t = 0; t < nt - 2; t += 2) {
        LDB(B0, 0, 0); SCHED; LDA(At, 0, 0); STAGE_A(SA(1, 1), 1, t + 1);
        WAIT_L(8); BAR; WAIT_L(0); MMA(0, 0, At, B0); BAR; SCHED;
        LDB(B1, 0, 1); STAGE_B(SB(0, 0), 0, t + 2);
        BAR; WAIT_L(0); MMA(0, 1, At, B1); BAR;
        LDA(At, 0, 1); STAGE_A(SA(0, 0), 0, t + 2);
        BAR; WAIT_L(0); MMA(1, 0, At, B0); BAR; SCHED;
        STAGE_B(SB(0, 1), 1, t + 2);
        WAIT_V(6); BAR; MMA(1, 1, At, B1); BAR;
        LDB(B0, 1, 0); SCHED; LDA(At, 1, 0); STAGE_A(SA(0, 1), 1, t + 2);
        WAIT_L(8); BAR; WAIT_L(0); MMA(0, 0, At, B0); BAR; SCHED;
        LDB(B1, 1, 1); STAGE_B(SB(1, 0), 0, t + 3);
        BAR; WAIT_L(0); MMA(0, 1, At, B1); BAR;
        LDA(At, 1, 1); STAGE_A(SA(1, 0), 0, t + 3);
        BAR; WAIT_L(0); MMA(1, 0, At, B0); BAR; SCHED;
        STAGE_B(SB(1, 1), 1, t + 3);
        WAIT_V(6); BAR; MMA(1, 1, At, B1); BAR;
    }
    { LDB(B0, 0, 0); LDA(At, 0, 0); STAGE_A(SA(1, 1), 1, nt - 1);
      BAR; WAIT_L(0); MMA(0, 0, At, B0); BAR;
      LDB(B1, 0, 1); BAR; WAIT_L(0); MMA(0, 1, At, B1); BAR;
      LDA(At, 0, 1); WAIT_V(4); BAR; WAIT_L(0); MMA(1, 0, At, B0); MMA(1, 1, At, B1); BAR; }
    { LDB(B0, 1, 0); LDA(At, 1, 0); WAIT_V(2); BAR; WAIT_L(0); MMA(0, 0, At, B0); BAR;
      LDB(B1, 1, 1); WAIT_V(0); BAR; WAIT_L(0); MMA(0, 1, At, B1); BAR;
      LDA(At, 1, 1); BAR; WAIT_L(0); MMA(1, 0, At, B0); MMA(1, 1, At, B1); BAR; }
    if (wr == 0) BAR;
#undef SA
#undef SB
#undef STAGE_A
#undef STAGE_B
#undef LDA
#undef LDB
#undef MMA
#undef WAIT_V
#undef WAIT_L
#undef BAR
#undef SCHED
}

DI void tile_decode(int L, int nN, int& pm, int& pn) {
    const int q = (256 * nN) >> 3, xcd = L & 7, off = L >> 3;
    const int wgid = xcd * q + off, nig = 8 * nN, gid = wgid / nig, rem = wgid % nig;
    pm = gid * 8 + (rem & 7); pn = rem >> 3;
}

DI void zero_acc(f32x4 (&acc)[2][2][4][2]) {
#pragma unroll
    for (int a = 0; a < 2; ++a)
#pragma unroll
        for (int b = 0; b < 2; ++b)
#pragma unroll
            for (int m = 0; m < 4; ++m)
#pragma unroll
                for (int n = 0; n < 2; ++n) acc[a][b][m][n] = (f32x4){0.f, 0.f, 0.f, 0.f};
}
#define EPI_LANES() int fr = fr0, fq = fq0; asm volatile("" : "+v"(fr), "+v"(fq))
DI f32x4 ld_bf16x4(const bf16_t* p) { const u32x2 w = *(const u32x2*)p; return (f32x4){__uint_as_float(w.x << 16), __uint_as_float(w.x & 0xffff0000u), __uint_as_float(w.y << 16), __uint_as_float(w.y & 0xffff0000u)}; }
DI float sumsq4(f32x4 v) { return v[0] * v[0] + v[1] * v[1] + v[2] * v[2] + v[3] * v[3]; }

DI float row_sumsq_reduce(float s) { s += __shfl_xor(s, 16); s += __shfl_xor(s, 32); return s; }

DI void prep_tile(const float* src, const float* src_alt, int Nsrc, const float* gain, const float* gain_hi, bf16_t* dst, int K, int mode,
                  int kt, int nt, float* tl, int tid) {
    const int k0 = kt * 64, n0 = nt * 64, tx = tid & 63, ty = tid >> 6;
    const int n = n0 + tx;
    const float* s = src; int sc = n; bool valid = true;
    if (mode == 1) {
        const int tile = n >> 8, within = n & 255;
        sc = tile * 128 + (within & 127); s = (within >> 7) ? src_alt : src;
    } else valid = n < Nsrc;
    for (int i = ty; i < 64; i += 8) {
        const int k = k0 + i;
        float v = valid ? s[(size_t)k * Nsrc + sc] : 0.f;
        float g = 1.f;
        if (gain) g = (gain_hi && k >= 512) ? gain_hi[k - 512] : gain[k];
        tl[i * 65 + tx] = v * g;
    }
    __syncthreads();
    const int r = tid >> 3, kc = (tid & 7) * 8;
    u32x4 w0;
    w0.x = cvt_pk(tl[(kc + 0) * 65 + r], tl[(kc + 1) * 65 + r]); w0.y = cvt_pk(tl[(kc + 2) * 65 + r], tl[(kc + 3) * 65 + r]);
    w0.z = cvt_pk(tl[(kc + 4) * 65 + r], tl[(kc + 5) * 65 + r]); w0.w = cvt_pk(tl[(kc + 6) * 65 + r], tl[(kc + 7) * 65 + r]);
    *(u32x4*)(dst + (size_t)(n0 + r) * K + k0 + kc) = w0;
    __syncthreads();
}

__device__ void phase0(const Params& p, unsigned char* smem, int tid) {
    float* tl = (float*)smem;
    constexpr int C0 = 320, C1 = C0 + 48, C2 = C1 + 32, C3 = C2 + 256, C4 = C3 + 1408, C5 = C4 + 704, C6 = C5 + 256, C7 = C6 + 64;
    for (int i = blockIdx.x; i < C7; i += gridDim.x) {
        if (i < C0)      { const int j = i;      prep_tile(p.w_in, nullptr, 1184, p.g_mix, nullptr, p.wt_in, 1024, 0, j % 16, j / 16, tl, tid); }
        else if (i < C1) { const int j = i - C0; prep_tile(p.w_uq, nullptr, 768, p.g_cq, nullptr, p.wt_uq, 256, 0, j % 4, j / 4, tl, tid); }
        else if (i < C2) { const int j = i - C1; prep_tile(p.w_ukv, nullptr, 1024, p.g_ckv, nullptr, p.wt_ukv, 128, 0, j % 2, j / 2, tl, tid); }
        else if (i < C3) { const int j = i - C2; prep_tile(p.w_o, nullptr, 1024, p.g_swa, p.g_mla, p.wt_o, 1024, 0, j % 16, j / 16, tl, tid); }
        else if (i < C4) { const int j = i - C3; prep_tile(p.w_gate, p.w_up, 2816, p.g_ffn, nullptr, p.wt_gu, 1024, 1, j % 16, j / 16, tl, tid); }
        else if (i < C5) { const int j = i - C4; prep_tile(p.w_down, nullptr, 1024, nullptr, nullptr, p.wt_d, 2816, 0, j % 44, j / 44, tl, tid); }
        else if (i < C6) { const int j = i - C5; prep_tile(p.w_pg, nullptr, 1024, p.g_ple, nullptr, p.wt_pg, 1024, 0, j % 16, j / 16, tl, tid); }
        else             { const int j = i - C6; prep_tile(p.w_pp, nullptr, 1024, nullptr, nullptr, p.wt_pp, 256, 0, j % 4, j / 4, tl, tid); }
    }
    const int lane = tid & 63, gw = blockIdx.x * (NTHR / 64) + (tid >> 6), nw = gridDim.x * (NTHR / 64);
    for (int row = gw; row < T; row += nw) {
        const float* xr = row < TP ? p.x_p + (size_t)row * 1024 : p.x_s + (size_t)(row - TP) * 1024;
        f32x4 v[4]; float ss = 0.f;
#pragma unroll
        for (int i = 0; i < 4; ++i) { v[i] = *(const f32x4*)(xr + (i * 64 + lane) * 4); ss += sumsq4(v[i]); }
#pragma unroll
        for (int o = 32; o >= 1; o >>= 1) ss += __shfl_xor(ss, o);
        if (lane == 0) p.rx[row] = 1.0f / sqrtf(ss * (1.0f / 1024.0f) + EPS);
#pragma unroll
        for (int i = 0; i < 4; ++i) st_bf16x4(p.xb + (size_t)row * 1024 + (i * 64 + lane) * 4, v[i]);
    }
    const int gt = blockIdx.x * NTHR + tid, nt = gridDim.x * NTHR;
    for (int idx = gt; idx < 16384 * 16; idx += nt) {
        const int s = idx >> 4, i = idx & 15;
        const float inv = (float)pow(10000.0, -(double)i / 16.0);
        const float ang = (float)s * inv;
        const double a = (double)ang;
        p.rope[idx] = (f32x2){(float)cos(a), (float)sin(a)};
    }
    for (int idx = gt; idx < 7 * T; idx += nt) p.rs_cq[idx] = 0.f;
}

DI void seq_of_row(int row, int& S, int& s) { if (row < TP) { S = 16384; s = row & 16383; } else { S = 4096; s = row & 4095; } }

__device__ void phase1(const Params& p, unsigned char* smem, int tid) {
    const int wid = __builtin_amdgcn_readfirstlane(tid >> 6), lane = tid & 63, wr = wid >> 2, wc = wid & 3, fr0 = lane & 15, fq0 = lane >> 4;
    for (int L = blockIdx.x; L < 256 * 5; L += gridDim.x) {
        int pm, pn; tile_decode(L, 5, pm, pn);
        f32x4 acc[2][2][4][2]; zero_acc(acc);
        gemm256(acc, p.xb + (size_t)pm * 256 * 1024, 1024, p.wt_in + (size_t)pn * 256 * 1024, 1024, 16, smem, tid);
        { EPI_LANES();

#pragma unroll
        for (int ai = 0; ai < 2; ++ai)
#pragma unroll
            for (int m = 0; m < 4; ++m) {
                asm volatile("" ::: "memory");
                const int row = pm * 256 + ai * 128 + wr * 64 + m * 16 + fr;
                const float r = p.rx[row];
                int S, s; seq_of_row(row, S, s);
                const int ct = wc * 32 + 4 * fq;
                if (pn < 2) {
#pragma unroll
                    for (int bj = 0; bj < 2; ++bj)
#pragma unroll
                        for (int n = 0; n < 2; ++n) st_bf16x4(p.qs + (size_t)row * 512 + pn * 256 + bj * 128 + ct + n * 16, acc[ai][bj][m][n] * (r * QSCALE_SWA));
                } else if (pn == 2) {
#pragma unroll
                    for (int n = 0; n < 2; ++n) st_bf16x4(p.ks + (size_t)row * 128 + ct + n * 16, acc[ai][0][m][n] * r);
                    bf16_t* vb = p.vst + (size_t)(row - s) * 128 + s;
#pragma unroll
                    for (int n = 0; n < 2; ++n)
#pragma unroll
                        for (int j = 0; j < 4; ++j) vb[(size_t)(ct + n * 16 + j) * S] = f2bf(acc[ai][1][m][n][j] * r);
                } else if (pn == 3) {
                    float ss = 0.f;
#pragma unroll
                    for (int bj = 0; bj < 2; ++bj)
#pragma unroll
                        for (int n = 0; n < 2; ++n) { const f32x4 v = acc[ai][bj][m][n] * r; ss += sumsq4(v); st_bf16x4(p.cq + (size_t)row * 256 + bj * 128 + ct + n * 16, v); }
                    ss = row_sumsq_reduce(ss);
                    if (fq == 0) atomic_addf(p.rs_cq + row, ss);
                } else {
                    float ss = 0.f;
#pragma unroll
                    for (int n = 0; n < 2; ++n) { const f32x4 v = acc[ai][0][m][n] * r; ss += sumsq4(v); st_bf16x4(p.ckv + (size_t)row * 128 + ct + n * 16, v); }
                    ss = row_sumsq_reduce(ss);
                    if (fq == 0) atomic_addf(p.rs_ckv + row, ss);
                    if (wc == 0) {
                        const f32x4 x1 = acc[ai][1][m][0] * r, x2 = acc[ai][1][m][1] * r; f32x4 o1, o2;
#pragma unroll
                        for (int j = 0; j < 4; ++j) { const f32x2 cs = p.rope[s * 16 + 4 * fq + j]; o1[j] = x1[j] * cs.x - x2[j] * cs.y; o2[j] = x2[j] * cs.x + x1[j] * cs.y; }
                        st_bf16x4(p.kr + (size_t)row * 32 + 4 * fq, o1);
                        st_bf16x4(p.kr + (size_t)row * 32 + 16 + 4 * fq, o2);
                    }
                }
            } }
    }
}

__device__ void phase2(const Params& p, unsigned char* smem, int tid) {
    const int wid = __builtin_amdgcn_readfirstlane(tid >> 6), lane = tid & 63, wr = wid >> 2, wc = wid & 3, fr0 = lane & 15, fq0 = lane >> 4;
    for (int L = blockIdx.x; L < 256 * 7; L += gridDim.x) {
        if (L < 256 * 3) {
            int pm, pn; tile_decode(L, 3, pm, pn);
            f32x4 acc[2][2][4][2]; zero_acc(acc);
            gemm256(acc, p.cq + (size_t)pm * 256 * 256, 256, p.wt_uq + (size_t)pn * 256 * 256, 256, 4, smem, tid);
            { EPI_LANES();

#pragma unroll
            for (int ai = 0; ai < 2; ++ai)
#pragma unroll
                for (int m = 0; m < 4; ++m) {
                    asm volatile("" ::: "memory");
                    const int row = pm * 256 + ai * 128 + wr * 64 + m * 16 + fr;
                    const float r = QSCALE_MLA / sqrtf(p.rs_cq[row] * (1.0f / 256.0f) + EPS);
                    int S, s; seq_of_row(row, S, s);
#pragma unroll
                    for (int bj = 0; bj < 2; ++bj) {
                        const int c0 = pn * 256 + bj * 128 + wc * 32;
                        f32x4 x1 = acc[ai][bj][m][0] * r, x2 = acc[ai][bj][m][1] * r;
                        if (((c0 >> 5) % 3) == 2) {
                            f32x4 o1, o2;
#pragma unroll
                            for (int j = 0; j < 4; ++j) { const f32x2 cs = p.rope[s * 16 + 4 * fq + j]; o1[j] = x1[j] * cs.x - x2[j] * cs.y; o2[j] = x2[j] * cs.x + x1[j] * cs.y; }
                            x1 = o1; x2 = o2;
                        }
                        st_bf16x4(p.qm + (size_t)row * 768 + c0 + 4 * fq, x1);
                        st_bf16x4(p.qm + (size_t)row * 768 + c0 + 16 + 4 * fq, x2);
                    }
                } }
        } else {
            int pm, pn; tile_decode(L - 256 * 3, 4, pm, pn);
            f32x4 acc[2][2][4][2]; zero_acc(acc);
            gemm256(acc, p.ckv + (size_t)pm * 256 * 128, 128, p.wt_ukv + (size_t)pn * 256 * 128, 128, 2, smem, tid);
            { EPI_LANES();

#pragma unroll
            for (int ai = 0; ai < 2; ++ai)
#pragma unroll
                for (int m = 0; m < 4; ++m) {
                    asm volatile("" ::: "memory");
                    const int row = pm * 256 + ai * 128 + wr * 64 + m * 16 + fr;
                    const float r = 1.0f / sqrtf(p.rs_ckv[row] * (1.0f / 128.0f) + EPS);
                    int S, s; seq_of_row(row, S, s);
#pragma unroll
                    for (int bj = 0; bj < 2; ++bj) {
                        const int head = pn * 2 + bj;
                        if (wc < 2) {
#pragma unroll
                            for (int n = 0; n < 2; ++n) st_bf16x4(p.km + (size_t)row * 512 + head * 64 + wc * 32 + n * 16 + 4 * fq, acc[ai][bj][m][n] * r);
                        } else {
                            bf16_t* vb = p.vmt + (size_t)(row - s) * 512 + (size_t)head * 64 * S + s;
#pragma unroll
                            for (int n = 0; n < 2; ++n)
#pragma unroll
                                for (int j = 0; j < 4; ++j) vb[(size_t)((wc - 2) * 32 + n * 16 + 4 * fq + j) * S] = f2bf(acc[ai][bj][m][n][j] * r);
                        }
                    }
                } }
        }
    }
}

DI bf16x8 pack8(const f32x16& x, int s8) {
    u32x4 w;
    w.x = cvt_pk(x[s8 + 0], x[s8 + 1]); w.y = cvt_pk(x[s8 + 2], x[s8 + 3]); w.z = cvt_pk(x[s8 + 4], x[s8 + 5]); w.w = cvt_pk(x[s8 + 6], x[s8 + 7]);
    return __builtin_bit_cast(bf16x8, w);
}

template <bool SWA>
DI void attn_item(const Params& p, unsigned char* smem, int tid, int tok0, int S, int head, int qb) {
    constexpr int NQ = SWA ? 4 : 6;
    constexpr int STG = 20480;
    const int w = tid >> 6, lane = tid & 63, r = lane & 31, h = lane >> 5;
    const int krow = (r & 3) | ((r & 4) << 1) | ((r & 8) >> 1) | (r & 16);
    const int kswz = (krow >> 1) & 7, krswz = (krow >> 2) & 3, vswz = (r >> 1) & 7;
    const int qpos = qb * 256 + w * 32 + r;
    const int q_tok = tok0 + qpos;
    bf16x8 qf[NQ];
    {
        const bf16_t* qptr = SWA ? p.qs + (size_t)q_tok * 512 + head * 64 : p.qm + (size_t)q_tok * 768 + head * 96;
#pragma unroll
        for (int ks = 0; ks < NQ; ++ks) qf[ks] = *(const bf16x8*)(qptr + ks * 16 + h * 8);
    }
    const int ldk = SWA ? 128 : 512;
    const bf16_t* kn_base = SWA ? p.ks + (size_t)tok0 * 128 + (head >> 2) * 64 : p.km + (size_t)tok0 * 512 + head * 64;
    const bf16_t* kr_base = p.kr + (size_t)tok0 * 32;
    const bf16_t* vt_base = SWA ? p.vst + (size_t)tok0 * 128 + (size_t)(head >> 2) * 64 * S : p.vmt + (size_t)tok0 * 512 + (size_t)head * 64 * S;
    int kt0 = 0, kt1 = S >> 6;
    if (SWA) { int lo = qb * 256 - 128, hi = qb * 256 + 384; lo = lo < 0 ? 0 : lo; hi = hi > S ? S : hi; kt0 = lo >> 6; kt1 = hi >> 6; }
    float slope2 = 0.f, mrun = -1e30f, lrun = 0.f;
    if (SWA) { slope2 = exp2f(-(float)(head + 1)) * LOG2E; mrun = p.sink[head] * LOG2E; lrun = h == 0 ? 1.f : 0.f; }

    f32x16 o0, o1;
#pragma unroll
    for (int i = 0; i < 16; ++i) { o0[i] = 0.f; o1[i] = 0.f; }

    auto stage = [&](int kt, int buf) {
        unsigned char* sb = smem + buf * STG;
        const int key0 = kt * 64;
        const int row = tid >> 3, ch = (tid & 7) ^ ((tid >> 4) & 7);
        glds16(kn_base + (size_t)(key0 + row) * ldk + ch * 8, sb + tid * 16);
        glds16(vt_base + (size_t)row * S + key0 + ch * 8, sb + 8192 + tid * 16);
        if (!SWA && tid < 256) {
            const int row4 = tid >> 2, c4 = (tid & 3) ^ ((row4 >> 2) & 3);
            glds16(kr_base + (size_t)(key0 + row4) * 32 + c4 * 8, sb + 16384 + tid * 16);
        }
    };

    stage(kt0, 0);
    for (int kt = kt0; kt < kt1; ++kt) {
        const int buf = (kt - kt0) & 1;
        asm volatile("s_waitcnt vmcnt(0)" ::: "memory");
        __syncthreads();
        if (kt + 1 < kt1) stage(kt + 1, buf ^ 1);
        const int key0 = kt * 64;
        bool active = true;
        if (SWA) { const int q0w = qb * 256 + w * 32; active = !(key0 > q0w + 31 + 128 || key0 + 63 < q0w - 128); }
        if (active) {
            const unsigned char* sb = smem + buf * STG;
            f32x16 s0, s1;
#pragma unroll
            for (int i = 0; i < 16; ++i) { s0[i] = 0.f; s1[i] = 0.f; }
#pragma unroll
            for (int ks = 0; ks < 4; ++ks) {
                const int co = ((2 * ks + h) ^ kswz) * 16;
                const bf16x8 a0 = *(const bf16x8*)(sb + krow * 128 + co);
                const bf16x8 a1 = *(const bf16x8*)(sb + (32 + krow) * 128 + co);
                s0 = __builtin_amdgcn_mfma_f32_32x32x16_bf16(a0, qf[ks], s0, 0, 0, 0);
                s1 = __builtin_amdgcn_mfma_f32_32x32x16_bf16(a1, qf[ks], s1, 0, 0, 0);
            }
            if (!SWA) {
#pragma unroll
                for (int ks = 0; ks < 2; ++ks) {
                    const int co = ((2 * ks + h) ^ krswz) * 16;
                    const bf16x8 a0 = *(const bf16x8*)(sb + 16384 + krow * 64 + co);
                    const bf16x8 a1 = *(const bf16x8*)(sb + 16384 + (32 + krow) * 64 + co);
                    s0 = __builtin_amdgcn_mfma_f32_32x32x16_bf16(a0, qf[NQ - 2 + ks], s0, 0, 0, 0);
                    s1 = __builtin_amdgcn_mfma_f32_32x32x16_bf16(a1, qf[NQ - 2 + ks], s1, 0, 0, 0);
                }
            }
            if (SWA) {
#pragma unroll
                for (int i = 0; i < 16; ++i) {
                    const int kidx = (i & 3) + 4 * ((i >> 2) & 1) + 8 * h + 16 * ((i >> 3) & 1);
                    const int d0 = key0 + kidx - qpos, d1 = d0 + 32;
                    const int a0 = d0 < 0 ? -d0 : d0, a1 = d1 < 0 ? -d1 : d1;
                    s0[i] = a0 <= 128 ? s0[i] - slope2 * (float)a0 : -1e30f;
                    s1[i] = a1 <= 128 ? s1[i] - slope2 * (float)a1 : -1e30f;
                }
            }
            float mx = fmaxf(s0[0], s1[0]);
#pragma unroll
            for (int i = 1; i < 16; ++i) mx = fmaxf(fmaxf(mx, s0[i]), s1[i]);
            mx = fmaxf(mx, __shfl_xor(mx, 32));
            if (__any(mx > mrun + 6.0f)) {
                const float mnew = fmaxf(mrun, mx);
                const float alpha = fexp2(mrun - mnew);
                mrun = mnew; lrun *= alpha;
#pragma unroll
                for (int i = 0; i < 16; ++i) { o0[i] *= alpha; o1[i] *= alpha; }
            }
            float ps = 0.f;
#pragma unroll
            for (int i = 0; i < 16; ++i) { s0[i] = fexp2(s0[i] - mrun); s1[i] = fexp2(s1[i] - mrun); ps += s0[i] + s1[i]; }
            lrun += ps;
            const unsigned char* sv = sb + 8192 + r * 128;
#pragma unroll
            for (int blk = 0; blk < 2; ++blk)
#pragma unroll
                for (int s = 0; s < 2; ++s) {
                    const bf16x8 pf = pack8(blk ? s1 : s0, 8 * s);
                    const int co = ((4 * blk + 2 * s + h) ^ vswz) * 16;
                    const bf16x8 v0 = *(const bf16x8*)(sv + co);
                    const bf16x8 v1 = *(const bf16x8*)(sv + 32 * 128 + co);
                    o0 = __builtin_amdgcn_mfma_f32_32x32x16_bf16(v0, pf, o0, 0, 0, 0);
                    o1 = __builtin_amdgcn_mfma_f32_32x32x16_bf16(v1, pf, o1, 0, 0, 0);
                }
        }
    }
    const float l = lrun + __shfl_xor(lrun, 32);
    const float inv = 1.0f / l;
    bf16_t* orow = p.o + (size_t)q_tok * 1024 + (SWA ? 0 : 512) + head * 64;
    float ss = 0.f;
#pragma unroll
    for (int g = 0; g < 4; ++g) {
        const f32x4 v0 = {o0[4 * g] * inv, o0[4 * g + 1] * inv, o0[4 * g + 2] * inv, o0[4 * g + 3] * inv};
        const f32x4 v1 = {o1[4 * g] * inv, o1[4 * g + 1] * inv, o1[4 * g + 2] * inv, o1[4 * g + 3] * inv};
        ss += sumsq4(v0) + sumsq4(v1);
        st_bf16x4(orow + 8 * g + 4 * h, v0);
        st_bf16x4(orow + 32 + 8 * g + 4 * h, v1);
    }
    ss += __shfl_xor(ss, 32);
    if (h == 0) atomic_addf((SWA ? p.rs_oswa : p.rs_omla) + q_tok, ss);
    __syncthreads();
}

template <int V>
DI void attn_mla_item(const Params& p, unsigned char* smem, int tid, int tok0, int S, int head, int qb) {
    constexpr int STG = 20480;
    const int w = __builtin_amdgcn_readfirstlane(tid >> 6), lane = tid & 63, r = lane & 31, h = lane >> 5;
    const int krow = (r & 3) | ((r & 4) << 1) | ((r & 8) >> 1) | (r & 16);
    const int kswz = (krow >> 1) & 7, krswz = (krow >> 2) & 3, vswz = (r >> 1) & 7;
    const int q_tok = tok0 + qb * 256 + w * 32 + r;
    bf16x8 qf[6];
    {
        const bf16_t* qptr = p.qm + (size_t)q_tok * 768 + head * 96;
#pragma unroll
        for (int ks = 0; ks < 6; ++ks) qf[ks] = *(const bf16x8*)(qptr + ks * 16 + h * 8);
    }
    const bf16_t* kn_base = p.km + (size_t)tok0 * 512 + head * 64;
    const bf16_t* kr_base = p.kr + (size_t)tok0 * 32;
    const bf16_t* vt_base = p.vmt + (size_t)tok0 * 512 + (size_t)head * 64 * S;
    const int nt = S >> 6;
    float mrun = -1e30f, lrun = 0.f;
    f32x16 o0, o1;
#pragma unroll
    for (int i = 0; i < 16; ++i) { o0[i] = 0.f; o1[i] = 0.f; }

    auto stage = [&](int kt, int buf) {
        unsigned char* sb = smem + buf * STG;
        const int key0 = kt * 64;
        const int row = tid >> 3, ch = (tid & 7) ^ ((tid >> 4) & 7);
        glds16(kn_base + (size_t)(key0 + row) * 512 + ch * 8, sb + tid * 16);
        glds16(vt_base + (size_t)row * S + key0 + ch * 8, sb + 8192 + tid * 16);
        if (w < 4) {
            const int row4 = tid >> 2, c4 = (tid & 3) ^ ((row4 >> 2) & 3);
            glds16(kr_base + (size_t)(key0 + row4) * 32 + c4 * 8, sb + 16384 + tid * 16);
        }
    };
    auto qk_tile = [&](const unsigned char* sb, f32x16& d0, f32x16& d1) {
#pragma unroll
        for (int i = 0; i < 16; ++i) { d0[i] = 0.f; d1[i] = 0.f; }
#pragma unroll
        for (int ks = 0; ks < 4; ++ks) {
            const int co = ((2 * ks + h) ^ kswz) * 16;
            const bf16x8 a0 = *(const bf16x8*)(sb + krow * 128 + co);
            const bf16x8 a1 = *(const bf16x8*)(sb + (32 + krow) * 128 + co);
            d0 = __builtin_amdgcn_mfma_f32_32x32x16_bf16(a0, qf[ks], d0, 0, 0, 0);
            d1 = __builtin_amdgcn_mfma_f32_32x32x16_bf16(a1, qf[ks], d1, 0, 0, 0);
        }
#pragma unroll
        for (int ks = 0; ks < 2; ++ks) {
            const int co = ((2 * ks + h) ^ krswz) * 16;
            const bf16x8 a0 = *(const bf16x8*)(sb + 16384 + krow * 64 + co);
            const bf16x8 a1 = *(const bf16x8*)(sb + 16384 + (32 + krow) * 64 + co);
            d0 = __builtin_amdgcn_mfma_f32_32x32x16_bf16(a0, qf[4 + ks], d0, 0, 0, 0);
            d1 = __builtin_amdgcn_mfma_f32_32x32x16_bf16(a1, qf[4 + ks], d1, 0, 0, 0);
        }
    };

    asm volatile("s_waitcnt vmcnt(0)" ::: "memory");
    stage(0, 0); stage(1, 1); stage(2, 2);
    if (w < 4) asm volatile("s_waitcnt vmcnt(6)" ::: "memory"); else asm volatile("s_waitcnt vmcnt(4)" ::: "memory");
    __builtin_amdgcn_s_barrier();
    asm volatile("" ::: "memory");
    f32x16 c0, c1;
    qk_tile(smem, c0, c1);
#pragma unroll 1
    for (int t = 0; t < nt; ++t) {
        if (t + 2 < nt) { if (w < 4) asm volatile("s_waitcnt vmcnt(3)" ::: "memory"); else asm volatile("s_waitcnt vmcnt(2)" ::: "memory"); }
        else asm volatile("s_waitcnt vmcnt(0)" ::: "memory");
        if (V != 2) __builtin_amdgcn_s_barrier();
        asm volatile("" ::: "memory");
        if (t + 3 < nt) stage(t + 3, (t + 3) & 3);
        float mx = fmaxf(c0[0], c1[0]);
#pragma unroll
        for (int i = 1; i < 16; ++i) mx = fmaxf(fmaxf(mx, c0[i]), c1[i]);
        if (V != 3 && __any(mx > mrun + 6.0f)) {
            mx = fmaxf(mx, __shfl_xor(mx, 32));
            const float mnew = fmaxf(mrun, mx);
            const float alpha = fexp2(mrun - mnew);
            mrun = mnew; lrun *= alpha;
#pragma unroll
            for (int i = 0; i < 16; ++i) { o0[i] *= alpha; o1[i] *= alpha; }
        }
        f32x16 n0, n1;
        qk_tile(smem + ((t + 1) & 3) * STG, n0, n1);
        float ps = 0.f;
#pragma unroll
        for (int i = 0; i < 16; ++i) { if (V != 1) { c0[i] = fexp2(c0[i] - mrun); c1[i] = fexp2(c1[i] - mrun); ps += c0[i] + c1[i]; } }
        lrun += ps;
        const unsigned char* sv = smem + (t & 3) * STG + 8192 + r * 128;
#pragma unroll
        for (int blk = 0; blk < 2; ++blk)
#pragma unroll
            for (int s = 0; s < 2; ++s) {
                const bf16x8 pf = pack8(blk ? c1 : c0, 8 * s);
                const int co = ((4 * blk + 2 * s + h) ^ vswz) * 16;
                const bf16x8 v0 = *(const bf16x8*)(sv + co);
                const bf16x8 v1 = *(const bf16x8*)(sv + 32 * 128 + co);
                o0 = __builtin_amdgcn_mfma_f32_32x32x16_bf16(v0, pf, o0, 0, 0, 0);
                o1 = __builtin_amdgcn_mfma_f32_32x32x16_bf16(v1, pf, o1, 0, 0, 0);
            }
        c0 = n0; c1 = n1;
    }
    const float l = lrun + __shfl_xor(lrun, 32);
    const float inv = 1.0f / l;
    bf16_t* orow = p.o + (size_t)q_tok * 1024 + 512 + head * 64;
    float ss = 0.f;
#pragma unroll
    for (int g = 0; g < 4; ++g) {
        const f32x4 v0 = {o0[4 * g] * inv, o0[4 * g + 1] * inv, o0[4 * g + 2] * inv, o0[4 * g + 3] * inv};
        const f32x4 v1 = {o1[4 * g] * inv, o1[4 * g + 1] * inv, o1[4 * g + 2] * inv, o1[4 * g + 3] * inv};
        ss += sumsq4(v0) + sumsq4(v1);
        st_bf16x4(orow + 8 * g + 4 * h, v0);
        st_bf16x4(orow + 32 + 8 * g + 4 * h, v1);
    }
    ss += __shfl_xor(ss, 32);
    if (h == 0) atomic_addf(p.rs_omla + q_tok, ss);
    __syncthreads();
}

DI void attn_mla2_item(const Params& p, unsigned char* smem, int tid, int tok0, int S, int head, int qb) {
    constexpr int STG = 20480;
    const int w = __builtin_amdgcn_readfirstlane(tid >> 6), lane = tid & 63, r = lane & 31, h = lane >> 5;
    const int krow = (r & 3) | ((r & 4) << 1) | ((r & 8) >> 1) | (r & 16);
    const int kswz = (krow >> 1) & 7, krswz = (krow >> 2) & 3, vswz = (r >> 1) & 7;
    const int q_tok = tok0 + qb * 512 + w * 64 + r;
    bf16x8 qa[6], qc[6];
    {
        const bf16_t* qptr = p.qm + (size_t)q_tok * 768 + head * 96;
#pragma unroll
        for (int ks = 0; ks < 6; ++ks) { qa[ks] = *(const bf16x8*)(qptr + ks * 16 + h * 8); qc[ks] = *(const bf16x8*)(qptr + 32 * 768 + ks * 16 + h * 8); }
    }
    const bf16_t* kn_base = p.km + (size_t)tok0 * 512 + head * 64;
    const bf16_t* kr_base = p.kr + (size_t)tok0 * 32;
    const bf16_t* vt_base = p.vmt + (size_t)tok0 * 512 + (size_t)head * 64 * S;
    const int nt = S >> 6;
    float mA = -1e30f, lA = 0.f, mB = -1e30f, lB = 0.f;
    f32x16 oa0, oa1, ob0, ob1;
#pragma unroll
    for (int i = 0; i < 16; ++i) { oa0[i] = 0.f; oa1[i] = 0.f; ob0[i] = 0.f; ob1[i] = 0.f; }

    auto stage = [&](int kt, int buf) {
        unsigned char* sb = smem + buf * STG;
        const int key0 = kt * 64;
        const int row = tid >> 3, ch = (tid & 7) ^ ((tid >> 4) & 7);
        glds16(kn_base + (size_t)(key0 + row) * 512 + ch * 8, sb + tid * 16);
        glds16(vt_base + (size_t)row * S + key0 + ch * 8, sb + 8192 + tid * 16);
        if (w < 4) {
            const int row4 = tid >> 2, c4 = (tid & 3) ^ ((row4 >> 2) & 3);
            glds16(kr_base + (size_t)(key0 + row4) * 32 + c4 * 8, sb + 16384 + tid * 16);
        }
    };

    asm volatile("s_waitcnt vmcnt(0)" ::: "memory");
    stage(0, 0); stage(1, 1); stage(2, 2);
#pragma unroll 1
    for (int t = 0; t < nt; ++t) {
        if (t + 2 < nt) { if (w < 4) asm volatile("s_waitcnt vmcnt(6)" ::: "memory"); else asm volatile("s_waitcnt vmcnt(4)" ::: "memory"); }
        else if (t + 1 < nt) { if (w < 4) asm volatile("s_waitcnt vmcnt(3)" ::: "memory"); else asm volatile("s_waitcnt vmcnt(2)" ::: "memory"); }
        else asm volatile("s_waitcnt vmcnt(0)" ::: "memory");
        __builtin_amdgcn_s_barrier();
        asm volatile("" ::: "memory");
        if (t + 3 < nt) stage(t + 3, (t + 3) & 3);
        const unsigned char* sb = smem + (t & 3) * STG;
        const unsigned char* sv = sb + 8192 + r * 128;
#pragma unroll
        for (int blk = 0; blk < 2; ++blk) {
            f32x16 as, bs;
#pragma unroll
            for (int i = 0; i < 16; ++i) { as[i] = 0.f; bs[i] = 0.f; }
#pragma unroll
            for (int ks = 0; ks < 4; ++ks) {
                const bf16x8 kf = *(const bf16x8*)(sb + (32 * blk + krow) * 128 + ((2 * ks + h) ^ kswz) * 16);
                as = __builtin_amdgcn_mfma_f32_32x32x16_bf16(kf, qa[ks], as, 0, 0, 0);
                bs = __builtin_amdgcn_mfma_f32_32x32x16_bf16(kf, qc[ks], bs, 0, 0, 0);
            }
#pragma unroll
            for (int ks = 0; ks < 2; ++ks) {
                const bf16x8 kf = *(const bf16x8*)(sb + 16384 + (32 * blk + krow) * 64 + ((2 * ks + h) ^ krswz) * 16);
                as = __builtin_amdgcn_mfma_f32_32x32x16_bf16(kf, qa[4 + ks], as, 0, 0, 0);
                bs = __builtin_amdgcn_mfma_f32_32x32x16_bf16(kf, qc[4 + ks], bs, 0, 0, 0);
            }
            float mxa = fmaxf(as[0], as[1]), mxb = fmaxf(bs[0], bs[1]);
#pragma unroll
            for (int i = 2; i < 16; i += 2) { mxa = fmaxf(fmaxf(mxa, as[i]), as[i + 1]); mxb = fmaxf(fmaxf(mxb, bs[i]), bs[i + 1]); }
            if (__any(mxa > mA + 6.0f || mxb > mB + 6.0f)) {
                mxa = fmaxf(mxa, __shfl_xor(mxa, 32)); mxb = fmaxf(mxb, __shfl_xor(mxb, 32));
                const float na = fmaxf(mA, mxa), nb = fmaxf(mB, mxb);
                const float fa = fexp2(mA - na), fb = fexp2(mB - nb);
                mA = na; mB = nb; lA *= fa; lB *= fb;
#pragma unroll
                for (int i = 0; i < 16; ++i) { oa0[i] *= fa; oa1[i] *= fa; ob0[i] *= fb; ob1[i] *= fb; }
            }
            float psa = 0.f, psb = 0.f;
#pragma unroll
            for (int i = 0; i < 16; ++i) { as[i] = fexp2(as[i] - mA); psa += as[i]; bs[i] = fexp2(bs[i] - mB); psb += bs[i]; }
            lA += psa; lB += psb;
#pragma unroll
            for (int s = 0; s < 2; ++s) {
                const bf16x8 pa = pack8(as, 8 * s);
                const bf16x8 pb = pack8(bs, 8 * s);
                const int co = ((4 * blk + 2 * s + h) ^ vswz) * 16;
                const bf16x8 v0 = *(const bf16x8*)(sv + co);
                const bf16x8 v1 = *(const bf16x8*)(sv + 32 * 128 + co);
                oa0 = __builtin_amdgcn_mfma_f32_32x32x16_bf16(v0, pa, oa0, 0, 0, 0);
                oa1 = __builtin_amdgcn_mfma_f32_32x32x16_bf16(v1, pa, oa1, 0, 0, 0);
                ob0 = __builtin_amdgcn_mfma_f32_32x32x16_bf16(v0, pb, ob0, 0, 0, 0);
                ob1 = __builtin_amdgcn_mfma_f32_32x32x16_bf16(v1, pb, ob1, 0, 0, 0);
            }
        }
    }
#pragma unroll
    for (int sub = 0; sub < 2; ++sub) {
        const float lr = sub ? lB : lA;
        const f32x16& x0 = sub ? ob0 : oa0; const f32x16& x1 = sub ? ob1 : oa1;
        const float l = lr + __shfl_xor(lr, 32);
        const float inv = 1.0f / l;
        const int tok = q_tok + 32 * sub;
        bf16_t* orow = p.o + (size_t)tok * 1024 + 512 + head * 64;
        float ss = 0.f;
#pragma unroll
        for (int g = 0; g < 4; ++g) {
            const f32x4 v0 = {x0[4 * g] * inv, x0[4 * g + 1] * inv, x0[4 * g + 2] * inv, x0[4 * g + 3] * inv};
            const f32x4 v1 = {x1[4 * g] * inv, x1[4 * g + 1] * inv, x1[4 * g + 2] * inv, x1[4 * g + 3] * inv};
            ss += sumsq4(v0) + sumsq4(v1);
            st_bf16x4(orow + 8 * g + 4 * h, v0);
            st_bf16x4(orow + 32 + 8 * g + 4 * h, v1);
        }
        ss += __shfl_xor(ss, 32);
        if (h == 0) atomic_addf(p.rs_omla + tok, ss);
    }
    __syncthreads();
}

template <int V>
__device__ void phase3(const Params& p, unsigned char* smem, int tid) {
    for (int I = blockIdx.x; I < 3072; I += gridDim.x) {
        if (I < 512) {
            const int rnd = I >> 8, B = I & 255, xcd = B & 7, slot = B >> 3;
            const int combo = xcd + 8 * rnd, qb = slot;
            if (V == 0) attn_mla2_item(p, smem, tid, (combo >> 3) * 16384, 16384, combo & 7, qb);
            else { attn_mla_item<V>(p, smem, tid, (combo >> 3) * 16384, 16384, combo & 7, 2 * qb); attn_mla_item<V>(p, smem, tid, (combo >> 3) * 16384, 16384, combo & 7, 2 * qb + 1); }
        } else if (I < 1024) {
            const int J = I - 512, rnd = J >> 8, B = J & 255, xcd = B & 7, slot = B >> 3;
            const int combo = xcd * 8 + rnd * 4 + (slot >> 3), qb = slot & 7;
            if (V == 0) attn_mla2_item(p, smem, tid, TP + (combo >> 3) * 4096, 4096, combo & 7, qb);
            else { attn_mla_item<V>(p, smem, tid, TP + (combo >> 3) * 4096, 4096, combo & 7, 2 * qb); attn_mla_item<V>(p, smem, tid, TP + (combo >> 3) * 4096, 4096, combo & 7, 2 * qb + 1); }
        } else {
            const int J = I - 1024, head = J >> 8, tb = (J & 255) * 256;
            int tok0, S;
            if (tb < TP) { tok0 = (tb >> 14) << 14; S = 16384; } else { tok0 = TP + (((tb - TP) >> 12) << 12); S = 4096; }
            attn_item<true>(p, smem, tid, tok0, S, head, (tb - tok0) >> 8);
        }
    }
}

__device__ void phase4(const Params& p, unsigned char* smem, int tid) {
    const int wid = __builtin_amdgcn_readfirstlane(tid >> 6), lane = tid & 63, wr = wid >> 2, wc = wid & 3, fr0 = lane & 15, fq0 = lane >> 4;
    for (int L = blockIdx.x; L < 256 * 4; L += gridDim.x) {
        int pm, pn; tile_decode(L, 4, pm, pn);
        f32x4 acc[2][2][4][2]; zero_acc(acc);
        const bf16_t* A = p.o + (size_t)pm * 256 * 1024; const bf16_t* B = p.wt_o + (size_t)pn * 256 * 1024;
        gemm256(acc, A, 1024, B, 1024, 8, smem, tid);
        { EPI_LANES();

#pragma unroll
        for (int ai = 0; ai < 2; ++ai)
#pragma unroll
            for (int m = 0; m < 4; ++m) {
                asm volatile("" ::: "memory");
                const int row = pm * 256 + ai * 128 + wr * 64 + m * 16 + fr;
                const float f = sqrtf((p.rs_omla[row] * (1.0f / 512.0f) + EPS) / (p.rs_oswa[row] * (1.0f / 512.0f) + EPS));
#pragma unroll
                for (int bj = 0; bj < 2; ++bj)
#pragma unroll
                    for (int n = 0; n < 2; ++n) acc[ai][bj][m][n] *= f;
            } }
        gemm256(acc, A + 512, 1024, B + 512, 1024, 8, smem, tid);
        { EPI_LANES();

#pragma unroll
        for (int ai = 0; ai < 2; ++ai)
#pragma unroll
            for (int m = 0; m < 4; ++m) {
                asm volatile("" ::: "memory");
                const int row = pm * 256 + ai * 128 + wr * 64 + m * 16 + fr;
                const float rm = 1.0f / sqrtf(p.rs_omla[row] * (1.0f / 512.0f) + EPS);
                const float* xr = row < TP ? p.x_p + (size_t)row * 1024 : p.x_s + (size_t)(row - TP) * 1024;
                float ss = 0.f;
#pragma unroll
                for (int bj = 0; bj < 2; ++bj)
#pragma unroll
                    for (int n = 0; n < 2; ++n) {
                        const int col = pn * 256 + bj * 128 + wc * 32 + n * 16 + 4 * fq;
                        const f32x4 hv = *(const f32x4*)(xr + col) + acc[ai][bj][m][n] * rm;
                        ss += sumsq4(hv);
                        st_bf16x4(p.hb + (size_t)row * 1024 + col, hv);
                    }
                ss = row_sumsq_reduce(ss);
                if (fq == 0) atomic_addf(p.rs_h1 + row, ss);
            } }
    }
}

__device__ void phase5(const Params& p, unsigned char* smem, int tid) {
    const int wid = __builtin_amdgcn_readfirstlane(tid >> 6), lane = tid & 63, wr = wid >> 2, wc = wid & 3, fr0 = lane & 15, fq0 = lane >> 4;
    for (int L = blockIdx.x; L < 256 * 22; L += gridDim.x) {
        int pm, pn; tile_decode(L, 22, pm, pn);
        f32x4 acc[2][2][4][2]; zero_acc(acc);
        gemm256(acc, p.hb + (size_t)pm * 256 * 1024, 1024, p.wt_gu + (size_t)pn * 256 * 1024, 1024, 16, smem, tid);
        { EPI_LANES();

#pragma unroll
        for (int ai = 0; ai < 2; ++ai)
#pragma unroll
            for (int m = 0; m < 4; ++m) {
                asm volatile("" ::: "memory");
                const int row = pm * 256 + ai * 128 + wr * 64 + m * 16 + fr;
                const float r = 1.0f / sqrtf(p.rs_h1[row] * (1.0f / 1024.0f) + EPS);
#pragma unroll
                for (int n = 0; n < 2; ++n) {
                    f32x4 a;
#pragma unroll
                    for (int j = 0; j < 4; ++j) { const float g = acc[ai][0][m][n][j] * r, u = acc[ai][1][m][n][j] * r; a[j] = g * u / (1.0f + __expf(-g)); }
                    st_bf16x4(p.act + (size_t)row * 2816 + pn * 128 + wc * 32 + n * 16 + 4 * fq, a);
                }
            } }
    }
}

__device__ void phase6(const Params& p, unsigned char* smem, int tid) {
    const int wid = __builtin_amdgcn_readfirstlane(tid >> 6), lane = tid & 63, wr = wid >> 2, wc = wid & 3, fr0 = lane & 15, fq0 = lane >> 4;
    for (int L = blockIdx.x; L < 256 * 4; L += gridDim.x) {
        int pm, pn; tile_decode(L, 4, pm, pn);
        f32x4 acc[2][2][4][2]; zero_acc(acc);
        gemm256(acc, p.act + (size_t)pm * 256 * 2816, 2816, p.wt_d + (size_t)pn * 256 * 2816, 2816, 44, smem, tid);
        { EPI_LANES();

#pragma unroll
        for (int ai = 0; ai < 2; ++ai)
#pragma unroll
            for (int m = 0; m < 4; ++m) {
                asm volatile("" ::: "memory");
                const int row = pm * 256 + ai * 128 + wr * 64 + m * 16 + fr;
                float ss = 0.f;
#pragma unroll
                for (int bj = 0; bj < 2; ++bj)
#pragma unroll
                    for (int n = 0; n < 2; ++n) {
                        const int col = pn * 256 + bj * 128 + wc * 32 + n * 16 + 4 * fq;
                        bf16_t* hp = p.hb + (size_t)row * 1024 + col;
                        const f32x4 hv = ld_bf16x4(hp) + acc[ai][bj][m][n];
                        ss += sumsq4(hv);
                        st_bf16x4(hp, hv);
                    }
                ss = row_sumsq_reduce(ss);
                if (fq == 0) atomic_addf(p.rs_h2 + row, ss);
            } }
    }
}

__device__ void phase_pb(const Params& p, int tid) {
    const int gt = blockIdx.x * NTHR + tid, nt = gridDim.x * NTHR;
    for (int idx = gt; idx < T * 64; idx += nt) {
        const int row = idx >> 6, c = (idx & 63) * 4;
        const float* pr = row < TP ? p.p_p + (size_t)row * 256 : p.p_s + (size_t)(row - TP) * 256;
        st_bf16x4(p.pb + (size_t)row * 256 + c, *(const f32x4*)(pr + c));
    }
}

__device__ void phase8(const Params& p, unsigned char* smem, int tid) {
    const int wid = __builtin_amdgcn_readfirstlane(tid >> 6), lane = tid & 63, wr = wid >> 2, wc = wid & 3, fr0 = lane & 15, fq0 = lane >> 4;
    for (int L = blockIdx.x; L < 256 * 4; L += gridDim.x) {
        int pm, pn; tile_decode(L, 4, pm, pn);
        f32x4 acc[2][2][4][2]; zero_acc(acc);
        gemm256(acc, p.pb + (size_t)pm * 256 * 256, 256, p.wt_pp + (size_t)pn * 256 * 256, 256, 4, smem, tid);
        { EPI_LANES();

#pragma unroll
        for (int ai = 0; ai < 2; ++ai)
#pragma unroll
            for (int m = 0; m < 4; ++m) {
                asm volatile("" ::: "memory");
                const int row = pm * 256 + ai * 128 + wr * 64 + m * 16 + fr;
#pragma unroll
                for (int bj = 0; bj < 2; ++bj)
#pragma unroll
                    for (int n = 0; n < 2; ++n) st_bf16x4(p.ppb + (size_t)row * 1024 + pn * 256 + bj * 128 + wc * 32 + n * 16 + 4 * fq, acc[ai][bj][m][n]);
            } }
        zero_acc(acc);
        gemm256(acc, p.hb + (size_t)pm * 256 * 1024, 1024, p.wt_pg + (size_t)pn * 256 * 1024, 1024, 16, smem, tid);
        { EPI_LANES();

#pragma unroll
        for (int ai = 0; ai < 2; ++ai)
#pragma unroll
            for (int m = 0; m < 4; ++m) {
                asm volatile("" ::: "memory");
                const int row = pm * 256 + ai * 128 + wr * 64 + m * 16 + fr;
                const float r = 1.0f / sqrtf(p.rs_h2[row] * (1.0f / 1024.0f) + EPS);
                float ss = 0.f;
#pragma unroll
                for (int bj = 0; bj < 2; ++bj)
#pragma unroll
                    for (int n = 0; n < 2; ++n) {
                        const int col = pn * 256 + bj * 128 + wc * 32 + n * 16 + 4 * fq;
                        float* op = p.out + (size_t)row * 1024 + col;
                        f32x4 hv = ld_bf16x4(p.hb + (size_t)row * 1024 + col);
                        const f32x4 pp = ld_bf16x4(p.ppb + (size_t)row * 1024 + col);
#pragma unroll
                        for (int j = 0; j < 4; ++j) { const float gt = 1.0f / (1.0f + __expf(-acc[ai][bj][m][n][j] * r)); hv[j] += gt * pp[j]; }
                        ss += sumsq4(hv);
                        *(f32x4*)op = hv;
                    }
                ss = row_sumsq_reduce(ss);
                if (fq == 0) atomic_addf(p.rs_h3 + row, ss);
            } }
    }
}

__device__ void phase9(const Params& p, int tid) {
    const int gt = blockIdx.x * NTHR + tid, nt = gridDim.x * NTHR;
    for (int idx = gt; idx < T * 256; idx += nt) {
        const int row = idx >> 8, c = (idx & 255) * 4;
        const float r = 1.0f / sqrtf(p.rs_h3[row] * (1.0f / 1024.0f) + EPS);
        float* op = p.out + (size_t)row * 1024 + c;
        const f32x4 g = *(const f32x4*)(p.g_final + c);
        *(f32x4*)op = *(const f32x4*)op * r * g;
    }
}

__global__ void __launch_bounds__(512, 2) mega(KArgs ka) {
    extern __shared__ __attribute__((aligned(16))) unsigned char smem[];
    const int tid = threadIdx.x;
    const int lo = ka.ph_lo, hi = ka.ph_hi;
#define RUN_PHASE(N, CALL) if (lo <= N && N < hi) { { const Params p = make_params(ka); CALL; } if (N + 1 < hi) cg::this_grid().sync(); }
#define RUN_PRE(N, CALL) if (N < PREFIX_K) { { const Params p = make_params(ka); CALL; } cg::this_grid().sync(); }
#if PREFIX_K > 0
    RUN_PRE(0, phase0(p, smem, tid))
    RUN_PRE(1, phase1(p, smem, tid))
    RUN_PRE(2, phase2(p, smem, tid))
    RUN_PRE(3, phase3<PROBE_V>(p, smem, tid))
    RUN_PRE(4, phase4(p, smem, tid))
    RUN_PRE(5, phase5(p, smem, tid))
    RUN_PRE(6, phase6(p, smem, tid))
#endif
    RUN_PHASE(0, phase0(p, smem, tid))
    RUN_PHASE(1, phase1(p, smem, tid))
    RUN_PHASE(2, phase2(p, smem, tid))
    RUN_PHASE(3, phase3<0>(p, smem, tid))
    RUN_PHASE(4, phase4(p, smem, tid))
    RUN_PHASE(5, phase5(p, smem, tid))
    RUN_PHASE(6, phase6(p, smem, tid))
    RUN_PHASE(7, phase_pb(p, tid))
    RUN_PHASE(8, phase8(p, smem, tid))
    RUN_PHASE(9, phase9(p, tid))
#undef RUN_PRE
#undef RUN_PHASE
}

extern "C" void kernel_launch(void* const* d_in, const int* in_sizes, int n_in, void* d_out, int out_size, void* d_ws, size_t ws_size, hipStream_t stream) {
    static int grid = 0;
    if (grid == 0) {
        int dev = 0, cus = 0, per_cu = 0;
        (void)hipGetDevice(&dev);
        (void)hipDeviceGetAttribute(&cus, hipDeviceAttributeMultiprocessorCount, dev);
        (void)hipFuncSetAttribute((const void*)mega, hipFuncAttributeMaxDynamicSharedMemorySize, LDS_BYTES);
        (void)hipOccupancyMaxActiveBlocksPerMultiprocessor(&per_cu, (const void*)mega, NTHR, LDS_BYTES);
        if (per_cu < 1) fprintf(stderr, "kernel_launch: occupancy query reports %d blocks per CU\n", per_cu);
        grid = cus;
        if (ws_size < ((size_t)512 << 20)) fprintf(stderr, "kernel_launch: workspace too small (%zu)\n", ws_size);
    }
    KArgs p{};
    for (int i = 0; i < 22; ++i) p.in[i] = (const float*)d_in[i];
    p.out = (float*)d_out; p.ws = (unsigned char*)d_ws;
#if MULTI_LAUNCH
    for (int ph = 0; ph < NPHASE; ++ph) {
        p.ph_lo = ph; p.ph_hi = ph + 1;
        hipLaunchKernelGGL(mega, dim3(grid), dim3(NTHR), LDS_BYTES, stream, p);
    }
#else
    p.ph_lo = 0; p.ph_hi = NPHASE;
    void* args[] = {&p};
    hipError_t e = hipLaunchCooperativeKernel((const void*)mega, dim3(grid), dim3(NTHR), args, LDS_BYTES, stream);
    if (e != hipSuccess) fprintf(stderr, "cooperative launch failed: %s (grid %d)\n", hipGetErrorString(e), grid);
#endif
}
```
